# Optimizing an MI355X kernel written in HIP

```python
import math
import jax, jax.numpy as jnp
from jax import lax
import numpy as np

D_MODEL = 1024
BATCH = 2
SEQ = 8192
DEPTH = 1

CHUNK = 64
Q_BLOCK = 128
HG_HEADS = 8
HG_DK = 128
HG_DV = D_MODEL // HG_HEADS
HG_KW = HG_HEADS * HG_DK
HG_VW = HG_HEADS * HG_DV
FOX_HEADS = 8
FOX_DH = 128
FOX_W = FOX_HEADS * FOX_DH
MEM_LEN = 256
MEM_HEADS = 4
MEM_DH = D_MODEL // MEM_HEADS
D_FF = 2816
N_BRANCH = 2
EPS = 1e-6
IN_SPLITS = [HG_KW, HG_KW, HG_VW, HG_VW, FOX_W, FOX_W, FOX_W, FOX_HEADS, N_BRANCH * D_MODEL]
IN_COLS = sum(IN_SPLITS)
IN_OFFSETS = list(np.cumsum(IN_SPLITS)[:-1])

kernel_name = "hgrn2_fox_macaron_sandwich_hybrid"


def rmsnorm(x, g):
    x32 = x.astype(jnp.float32)
    y = x32 * lax.rsqrt(jnp.mean(x32 * x32, axis=-1, keepdims=True) + EPS)
    return (y * g.astype(jnp.float32)).astype(x.dtype)


def swiglu(h, w_in, w_down):
    gate, up = jnp.split(h @ w_in, 2, axis=-1)
    return (jax.nn.silu(gate) * up) @ w_down


def hgrn2_chunkwise(q, f_logit, inp, lb):
    B, S = q.shape[0], q.shape[1]
    n = S // CHUNK
    f = lb + (1.0 - lb) * jax.nn.sigmoid(f_logit.astype(jnp.float32))
    logf = jnp.log(f)
    k = 1.0 - f
    q = jax.nn.silu(q.astype(jnp.float32))
    inp = inp.astype(jnp.float32)

    def to_chunks(t):
        return t.reshape(B, n, CHUNK, t.shape[2], t.shape[3]).transpose(1, 0, 3, 2, 4)

    qc, kc, ic = to_chunks(q), to_chunks(k), to_chunks(inp)
    bc = jnp.cumsum(to_chunks(logf), axis=3)
    mask = jnp.tril(jnp.ones((CHUNK, CHUNK), dtype=bool))[:, :, None]

    def step(state, xs):
        qt, kt, it, bt = xs
        diff = bt[:, :, :, None, :] - bt[:, :, None, :, :]
        decay = jnp.exp(jnp.where(mask, diff, -jnp.inf))
        a = jnp.einsum('bhtd,bhsd,bhtsd->bhts', qt, kt, decay)
        o_intra = jnp.einsum('bhts,bhsv->bhtv', a, it)
        o_inter = jnp.einsum('bhtd,bhdv->bhtv', qt * jnp.exp(bt), state)
        b_last = bt[:, :, -1:, :]
        new_state = jnp.exp(b_last[:, :, 0, :])[..., None] * state + jnp.einsum(
            'bhsd,bhsv->bhdv', kt * jnp.exp(b_last - bt), it)
        return new_state, o_intra + o_inter

    s0 = jnp.zeros((B, q.shape[2], HG_DK, HG_DV), jnp.float32)
    _, o = lax.scan(step, s0, (qc, kc, ic, bc))
    return o.transpose(1, 0, 3, 2, 4).reshape(B, S, HG_VW)


def fox_attention(q, k, v, f_logit):
    B, S, H, dh = q.shape
    n_blk = S // Q_BLOCK
    scale = 1.0 / math.sqrt(dh)
    c = jnp.cumsum(jax.nn.log_sigmoid(f_logit.astype(jnp.float32)), axis=1).transpose(0, 2, 1)
    k32 = k.astype(jnp.float32)
    v32 = v.astype(jnp.float32)
    qb = q.astype(jnp.float32).reshape(B, n_blk, Q_BLOCK, H, dh).transpose(1, 0, 3, 2, 4)
    cb = c.reshape(B, H, n_blk, Q_BLOCK).transpose(2, 0, 1, 3)
    kpos = jnp.arange(S)

    def block(args):
        qi, ci, blk = args
        s = jnp.einsum('bhqd,bkhd->bhqk', qi, k32) * scale
        s = s + ci[..., None] - c[:, :, None, :]
        qpos = blk * Q_BLOCK + jnp.arange(Q_BLOCK)
        s = jnp.where(kpos[None, :] <= qpos[:, None], s, -jnp.inf)
        p = jax.nn.softmax(s, axis=-1)
        return jnp.einsum('bhqk,bkhd->bqhd', p, v32)

    o = lax.map(block, (qb, cb, jnp.arange(n_blk)))
    return o.transpose(1, 0, 2, 3, 4).reshape(B, S, H * dh)


def mem_cross_attention(h, mem_n, w_mq, w_mkv, w_mo):
    B, S, _ = h.shape
    q = (h @ w_mq).reshape(B, S, MEM_HEADS, MEM_DH).astype(jnp.float32)
    k, v = jnp.split(mem_n @ w_mkv, 2, axis=-1)
    k = k.reshape(B, MEM_LEN, MEM_HEADS, MEM_DH).astype(jnp.float32)
    v = v.reshape(B, MEM_LEN, MEM_HEADS, MEM_DH).astype(jnp.float32)
    s = jnp.einsum('bqhd,bkhd->bhqk', q, k) * (1.0 / math.sqrt(MEM_DH))
    p = jax.nn.softmax(s, axis=-1)
    o = jnp.einsum('bhqk,bkhd->bqhd', p, v).reshape(B, S, D_MODEL).astype(h.dtype)
    return o @ w_mo


def setup_inputs(seed: int = 0) -> dict:
    key = jax.random.key(seed)
    ks = iter(jax.random.split(key, 40))
    f32 = jnp.float32

    def w(shape, fan_in):
        return jax.random.normal(next(ks), shape, f32) * (fan_in ** -0.5)

    def gain(shape):
        return 1.0 + 0.05 * jax.random.normal(next(ks), shape, f32)

    L, D = DEPTH, D_MODEL
    return {
        "x": jax.random.normal(next(ks), (BATCH, SEQ, D), f32),
        "mem": jax.random.normal(next(ks), (BATCH, MEM_LEN, D), f32),
        "ffn1_pre_g": gain((L, D)),
        "ffn1_w_in": w((L, D, 2 * D_FF), D),
        "ffn1_w_down": w((L, D_FF, D), D_FF),
        "ffn1_post_g": gain((L, D)),
        "mix_pre_g": gain((L, D)),
        "w_in": w((L, D, IN_COLS), D),
        "hg_lb_logits": 0.5 * jax.random.normal(next(ks), (L + 1, HG_HEADS, HG_DK), f32),
        "hg_norm_g": gain((L, HG_VW)),
        "fox_f_bias": 1.0 + 0.5 * jax.random.normal(next(ks), (L, FOX_HEADS), f32),
        "w_branch_a": w((L, HG_VW, D), HG_VW),
        "w_branch_b": w((L, FOX_W, D), FOX_W),
        "b_gate": 0.02 * jax.random.normal(next(ks), (L, N_BRANCH * D), f32),
        "w_out": w((L, D, D), D),
        "mix_post_g": gain((L, D)),
        "mem_pre_g": gain((L, D)),
        "mem_kv_g": gain((L, D)),
        "w_mq": w((L, D, D), D),
        "w_mkv": w((L, D, 2 * D), D),
        "w_mo": w((L, D, D), D),
        "mem_post_g": gain((L, D)),
        "ffn2_pre_g": gain((L, D)),
        "ffn2_w_in": w((L, D, 2 * D_FF), D),
        "ffn2_w_down": w((L, D_FF, D), D_FF),
        "ffn2_post_g": gain((L, D)),
    }


def reference(x, mem, ffn1_pre_g, ffn1_w_in, ffn1_w_down, ffn1_post_g,
              mix_pre_g, w_in, hg_lb_logits, hg_norm_g, fox_f_bias,
              w_branch_a, w_branch_b, b_gate, w_out, mix_post_g,
              mem_pre_g, mem_kv_g, w_mq, w_mkv, w_mo, mem_post_g,
              ffn2_pre_g, ffn2_w_in, ffn2_w_down, ffn2_post_g):
    B, S, D = x.shape
    lb_all = jnp.cumsum(jax.nn.softmax(hg_lb_logits.astype(jnp.float32), axis=0), axis=0)
    for l in range(DEPTH):
        h = rmsnorm(x, ffn1_pre_g[l])
        x = x + 0.5 * rmsnorm(swiglu(h, ffn1_w_in[l], ffn1_w_down[l]), ffn1_post_g[l])

        h = rmsnorm(x, mix_pre_g[l])
        q_a, f_a, i_a, g_a, q_b, k_b, v_b, f_b, gates = jnp.split(h @ w_in[l], IN_OFFSETS, axis=-1)

        o_a = hgrn2_chunkwise(q_a.reshape(B, S, HG_HEADS, HG_DK),
                              f_a.reshape(B, S, HG_HEADS, HG_DK),
                              i_a.reshape(B, S, HG_HEADS, HG_DV), lb_all[l])
        o_a = rmsnorm(o_a.astype(x.dtype), hg_norm_g[l]) * jax.nn.silu(g_a)
        y_a = o_a @ w_branch_a[l]

        o_b = fox_attention(q_b.reshape(B, S, FOX_HEADS, FOX_DH),
                            k_b.reshape(B, S, FOX_HEADS, FOX_DH),
                            v_b.reshape(B, S, FOX_HEADS, FOX_DH),
                            f_b + fox_f_bias[l])
        y_b = o_b.astype(x.dtype) @ w_branch_b[l]

        gate = jax.nn.sigmoid((gates + b_gate[l]).astype(jnp.float32)).reshape(B, S, N_BRANCH, D)
        y = (gate[:, :, 0] * y_a.astype(jnp.float32) + gate[:, :, 1] * y_b.astype(jnp.float32)).astype(x.dtype)
        x = x + rmsnorm(y @ w_out[l], mix_post_g[l])

        h = rmsnorm(x, mem_pre_g[l])
        mem_n = rmsnorm(mem, mem_kv_g[l])
        x = x + rmsnorm(mem_cross_attention(h, mem_n, w_mq[l], w_mkv[l], w_mo[l]), mem_post_g[l])

        h = rmsnorm(x, ffn2_pre_g[l])
        x = x + 0.5 * rmsnorm(swiglu(h, ffn2_w_in[l], ffn2_w_down[l]), ffn2_post_g[l])
    return x
```

```cpp
#include <hip/hip_runtime.h>
#include <hip/hip_cooperative_groups.h>
#include <cstdio>
#include <cstdint>
#include <cmath>
namespace cg = cooperative_groups;
__device__ __forceinline__ int fresh_lane() { int l; asm volatile("v_mbcnt_lo_u32_b32 %0, -1, 0\n\tv_mbcnt_hi_u32_b32 %0, -1, %0" : "=v"(l)); return l; }
namespace pg8 {
#define PG8_LAS __attribute__((address_space(3)))
typedef unsigned short bf16_t;
typedef short bf16x8 __attribute__((ext_vector_type(8)));
typedef float f32x4 __attribute__((ext_vector_type(4)));
typedef unsigned u32x4 __attribute__((ext_vector_type(4)));
constexpr int BM = 256, BK = 64, HALF = 128, HTB = HALF * BK * 2  , STAGE_BYTES = 8 * HTB, NXCD = 8, WGM = 8;

__host__ __device__ __forceinline__ int lds_byte(int r, int c) { const int st = (r >> 4) * 2 + (c >> 5), rr = r & 15, cc = c & 31, ob = rr * 64 + cc * 2; return st * 1024 + (ob ^ (((ob >> 9) & 1) << 5)); }
__host__ __device__ __forceinline__ void stage_rc(int b, int& R, int& C) { const int st = b / 1024, sb = b % 1024, swz = sb ^ (((sb >> 9) & 1) << 5); R = (st >> 1) * 16 + swz / 64; C = (st & 1) * 32 + (swz % 64) / 2; }
__host__ __device__ __forceinline__ int perm32(int rho) { const int n = rho >> 4, i = rho & 15; return 8 * (i >> 2) + 4 * n + (i & 3); }

struct Unit { int pm, pn; };
struct Gemm { const bf16_t* A; const bf16_t* Bt; int M, N, K; };

struct StaticOrder {
    int nM, nN, nwg, G, c;
    __host__ __device__ void init(int M, int N, int G_, int c_) { nM = M / BM; nN = N / BM; nwg = nM * nN; G = G_; c = c_; }
    __host__ __device__ bool next(int i, Unit& u) const {
        const long L = (long)i * G + c; if (L >= nwg) return false;
        int wgid = (int)L; { const int q = nwg / NXCD, r = nwg % NXCD, xcd = wgid % NXCD, off = wgid / NXCD; wgid = (xcd < r ? xcd * (q + 1) : r * (q + 1) + (xcd - r) * q) + off; }
        const int nig = WGM * nN, gid = wgid / nig, fm = gid * WGM, gsz = (nM - fm) < WGM ? (nM - fm) : WGM;
        u.pm = fm + ((wgid % nig) % gsz); u.pn = (wgid % nig) / gsz; return true;
    }
    __device__ __forceinline__ const char* pa(const Gemm& g, const Unit& u) const { return (const char*)g.A + (size_t)u.pm * ((size_t)BM * g.K * 2); }
    __device__ __forceinline__ const char* pb(const Gemm& g, const Unit& u) const { return (const char*)g.Bt + (size_t)u.pn * ((size_t)BM * g.K * 2); }
    __device__ __forceinline__ void a_ready(const Unit&) const {}
    __device__ __forceinline__ void done(const Unit&) const {}
};


struct ListOrder {
    int nM, c0, n, c;
    __device__ bool next(int i, Unit& u) const { const int idx = c - c0; if (i != 0 || idx < 0 || idx >= n) return false; u.pm = idx % nM; u.pn = idx / nM; return true; }
    __device__ __forceinline__ const char* pa(const Gemm& g, const Unit& u) const { return (const char*)g.A + (size_t)u.pm * ((size_t)BM * g.K * 2); }
    __device__ __forceinline__ const char* pb(const Gemm& g, const Unit& u) const { return (const char*)g.Bt + (size_t)u.pn * ((size_t)BM * g.K * 2); }
    __device__ __forceinline__ void a_ready(const Unit&) const {}
    __device__ __forceinline__ void done(const Unit&) const {}
};
struct CrossOrder {
    StaticOrder so; int Mrows, pm_per_batch;
    __device__ bool next(int i, Unit& u) const { return so.next(i, u); }
    __device__ __forceinline__ const char* pa(const Gemm& g, const Unit& u) const { return (const char*)g.A + ((size_t)u.pn * Mrows + (size_t)u.pm * BM) * ((size_t)g.K * 2); }
    __device__ __forceinline__ const char* pb(const Gemm& g, const Unit& u) const { return (const char*)g.Bt + ((size_t)(u.pn * 2 + u.pm / pm_per_batch) * BM) * ((size_t)g.K * 2); }
    __device__ __forceinline__ void a_ready(const Unit&) const {}
    __device__ __forceinline__ void done(const Unit&) const {}
};

__device__ __forceinline__ unsigned f2bf_(float f) { unsigned u = __builtin_bit_cast(unsigned, f); return (u + 0x7fffu + ((u >> 16) & 1u)) >> 16; }
__device__ __forceinline__ unsigned pk2_(float lo, float hi) { return f2bf_(lo) | (f2bf_(hi) << 16); }
__device__ __forceinline__ float bf2f_(unsigned v) { return __builtin_bit_cast(float, v << 16); }
typedef unsigned u32x2 __attribute__((ext_vector_type(2)));
__device__ __forceinline__ void st_bf4(bf16_t* p, f32x4 v) { u32x2 w; w.x = pk2_(v[0], v[1]); w.y = pk2_(v[2], v[3]); *(u32x2*)p = w; }
__device__ __forceinline__ f32x4 ld_bf4(const bf16_t* p) { const u32x2 w = *(const u32x2*)p; return (f32x4){bf2f_(w.x & 0xffffu), bf2f_(w.x >> 16), bf2f_(w.y & 0xffffu), bf2f_(w.y >> 16)}; }
__device__ __forceinline__ float sigm(float x) { return 1.0f / (1.0f + __expf(-x)); }
__device__ __forceinline__ float silu_(float x) { return x / (1.0f + __expf(-x)); }

#define PG8_FOREACH_BEGIN \
    _Pragma("unroll") for (int ai = 0; ai < 2; ++ai) _Pragma("unroll") for (int m = 0; m < 4; ++m) { const int row = u.pm * BM + ai * HALF + wr * 64 + m * 16 + fr; \
    _Pragma("unroll") for (int bj = 0; bj < 2; ++bj) _Pragma("unroll") for (int n = 0; n < 2; ++n) { const int col = u.pn * BM + bj * HALF + wc * 32 + n * 16 + 4 * fq; const f32x4 v = acc[ai][bj][m][n];
#define PG8_FOREACH_END } }

struct EpiF32 {
    static constexpr bool PERM = false, AFTER_DRAIN = false; float* O; int ldc;
    __device__ __forceinline__ void operator()(const f32x4 (&acc)[2][2][4][2], const Unit& u, int wr, int wc, int fr, int fq) const {
        PG8_FOREACH_BEGIN *(f32x4*)(O + (size_t)row * ldc + col) = v; PG8_FOREACH_END
    }
};
struct EpiBf16P {
    static constexpr bool PERM = false, AFTER_DRAIN = false; bf16_t* O; int ldc; float sc;
    __device__ __forceinline__ void operator()(const f32x4 (&acc)[2][2][4][2], const Unit& u, int wr, int wc, int fr, int fq) const {
        PG8_FOREACH_BEGIN st_bf4(O + (size_t)row * ldc + col, v * sc); PG8_FOREACH_END
    }
};
struct EpiSwiglu {
    static constexpr bool PERM = false, AFTER_DRAIN = false; bf16_t* O; int ldc;
    __device__ __forceinline__ void operator()(const f32x4 (&acc)[2][2][4][2], const Unit& u, int wr, int wc, int fr, int fq) const {
#pragma unroll
        for (int ai = 0; ai < 2; ++ai)
#pragma unroll
            for (int m = 0; m < 4; ++m) { const int row = u.pm * BM + ai * HALF + wr * 64 + m * 16 + fr;
#pragma unroll
                for (int n = 0; n < 2; ++n) { const int col = u.pn * HALF + wc * 32 + n * 16 + 4 * fq; const f32x4 g = acc[ai][0][m][n], up = acc[ai][1][m][n];
                    f32x4 h; h[0] = silu_(g[0]) * up[0]; h[1] = silu_(g[1]) * up[1]; h[2] = silu_(g[2]) * up[2]; h[3] = silu_(g[3]) * up[3];
                    st_bf4(O + (size_t)row * ldc + col, h); } }
    }
};
struct EpiInproj {
    static constexpr bool PERM = false, AFTER_DRAIN = false;
    bf16_t *QA, *LF, *GA, *QB, *KB, *GT; const float* lbl; const float* bgate; float qscale;
    __device__ __forceinline__ void operator()(const f32x4 (&acc)[2][2][4][2], const Unit& u, int wr, int wc, int fr, int fq) const {
        const int cls = u.pn >> 2;
        if (cls == 0 || cls == 2) { bf16_t* O = cls == 0 ? QA : GA; const int c0 = cls * 1024;
            PG8_FOREACH_BEGIN f32x4 o; o[0] = silu_(v[0]); o[1] = silu_(v[1]); o[2] = silu_(v[2]); o[3] = silu_(v[3]); st_bf4(O + (size_t)row * 1024 + (col - c0), o); PG8_FOREACH_END
        } else if (cls == 1) {
            PG8_FOREACH_BEGIN const int c = col - 1024; const f32x4 l0 = *(const f32x4*)(lbl + c), l1 = *(const f32x4*)(lbl + 1024 + c); f32x4 o;
#pragma unroll
                for (int e = 0; e < 4; ++e) { const float lb = 1.0f / (1.0f + __expf(l1[e] - l0[e])); const float f = lb + (1.0f - lb) * sigm(v[e]); o[e] = __logf(f); }
                st_bf4(LF + (size_t)row * 1024 + c, o); PG8_FOREACH_END
        } else if (cls == 3) {
            PG8_FOREACH_BEGIN st_bf4(QB + (size_t)row * 1024 + (col - 3072), v * qscale); PG8_FOREACH_END
        } else if (cls == 4) {
            PG8_FOREACH_BEGIN st_bf4(KB + (size_t)row * 1024 + (col - 4096), v); PG8_FOREACH_END
        } else {
            PG8_FOREACH_BEGIN const int c = col - 5120; const f32x4 bg = *(const f32x4*)(bgate + c); f32x4 o; o[0] = sigm(v[0] + bg[0]); o[1] = sigm(v[1] + bg[1]); o[2] = sigm(v[2] + bg[2]); o[3] = sigm(v[3] + bg[3]);
                st_bf4(GT + (size_t)row * 2048 + c, o); PG8_FOREACH_END
        }
    }
};
struct EpiBranchA {
    static constexpr bool PERM = false, AFTER_DRAIN = false; bf16_t* GT; const float* rstd;
    __device__ __forceinline__ void operator()(const f32x4 (&acc)[2][2][4][2], const Unit& u, int wr, int wc, int fr, int fq) const {
        const float* rs = rstd + (size_t)u.pn * 16384;
        PG8_FOREACH_BEGIN bf16_t* p = GT + (size_t)row * 2048 + col; const f32x4 g0 = ld_bf4(p); const float r = rs[row]; st_bf4(p, g0 * v * r); PG8_FOREACH_END
    }
};
struct EpiBranchB {
    static constexpr bool PERM = false, AFTER_DRAIN = false; const bf16_t* GT; bf16_t* Y;
    __device__ __forceinline__ void operator()(const f32x4 (&acc)[2][2][4][2], const Unit& u, int wr, int wc, int fr, int fq) const {
        PG8_FOREACH_BEGIN const bf16_t* p = GT + (size_t)row * 2048 + col; const f32x4 t = ld_bf4(p), g1 = ld_bf4(p + 1024); st_bf4(Y + (size_t)row * 1024 + col, t + g1 * v); PG8_FOREACH_END
    }
};
struct EpiHeadSplit {
    static constexpr bool PERM = false, AFTER_DRAIN = false; bf16_t* O; int Mrows; float sc;
    __device__ __forceinline__ void operator()(const f32x4 (&acc)[2][2][4][2], const Unit& u, int wr, int wc, int fr, int fq) const {
        PG8_FOREACH_BEGIN st_bf4(O + ((size_t)u.pn * Mrows + row) * 256 + (col - u.pn * BM), v * sc); PG8_FOREACH_END
    }
};
struct EpiMemKV {
    static constexpr bool PERM = false, AFTER_DRAIN = false; bf16_t *KM, *VTM;
    __device__ __forceinline__ void operator()(const f32x4 (&acc)[2][2][4][2], const Unit& u, int wr, int wc, int fr, int fq) const {
        if (u.pn < 4) { PG8_FOREACH_BEGIN st_bf4(KM + ((size_t)u.pn * 512 + row) * 256 + (col - u.pn * BM), v); PG8_FOREACH_END }
        else { const int h = u.pn - 4;
            PG8_FOREACH_BEGIN const int d = col - u.pn * BM, b = row >> 8, key = row & 255; bf16_t* p = VTM + ((size_t)(h * 2 + b) * 256 + d) * 256 + key;
                p[0] = (bf16_t)f2bf_(v[0]); p[256] = (bf16_t)f2bf_(v[1]); p[512] = (bf16_t)f2bf_(v[2]); p[768] = (bf16_t)f2bf_(v[3]); PG8_FOREACH_END }
    }
};
struct EpiSoftmax {
    static constexpr bool PERM = false, AFTER_DRAIN = true; bf16_t* P; int Mrows;
    __device__ __forceinline__ void fused(f32x4 (&acc)[2][2][4][2], const Unit& u, int wr, int wc, int fr, int fq, PG8_LAS unsigned char* lds, int wid, int lane) const {
        typedef float f32x2v __attribute__((ext_vector_type(2)));
        PG8_LAS f32x2v* X = (PG8_LAS f32x2v*)lds;
        float mx[2][4];
#pragma unroll
        for (int ai = 0; ai < 2; ++ai)
#pragma unroll
            for (int m = 0; m < 4; ++m) { float a = -INFINITY;
#pragma unroll
                for (int bj = 0; bj < 2; ++bj)
#pragma unroll
                    for (int n = 0; n < 2; ++n) { const f32x4 v = acc[ai][bj][m][n]; a = fmaxf(a, fmaxf(fmaxf(v[0], v[1]), fmaxf(v[2], v[3]))); }
                a = fmaxf(a, __shfl_xor(a, 16)); a = fmaxf(a, __shfl_xor(a, 32)); float s = 0.f;
#pragma unroll
                for (int bj = 0; bj < 2; ++bj)
#pragma unroll
                    for (int n = 0; n < 2; ++n) { const f32x4 v = acc[ai][bj][m][n]; s += (__builtin_amdgcn_exp2f(v[0] - a) + __builtin_amdgcn_exp2f(v[1] - a)) + (__builtin_amdgcn_exp2f(v[2] - a) + __builtin_amdgcn_exp2f(v[3] - a)); }
                s += __shfl_xor(s, 16); s += __shfl_xor(s, 32); mx[ai][m] = a;
                if (fq == 0) X[(ai * HALF + wr * 64 + m * 16 + fr) * 4 + wc] = (f32x2v){a, s}; }
        asm volatile("s_waitcnt lgkmcnt(0)" ::: "memory"); __builtin_amdgcn_s_barrier(); asm volatile("" ::: "memory");
#pragma unroll
        for (int ai = 0; ai < 2; ++ai)
#pragma unroll
            for (int m = 0; m < 4; ++m) { const int rl = ai * HALF + wr * 64 + m * 16 + fr; const f32x2v a = X[rl * 4 + 0], b = X[rl * 4 + 1], c = X[rl * 4 + 2], d = X[rl * 4 + 3];
                const float gm = fmaxf(fmaxf(a.x, b.x), fmaxf(c.x, d.x));
                const float gs = (a.y * __builtin_amdgcn_exp2f(a.x - gm) + b.y * __builtin_amdgcn_exp2f(b.x - gm)) + (c.y * __builtin_amdgcn_exp2f(c.x - gm) + d.y * __builtin_amdgcn_exp2f(d.x - gm));
                const float inv = 1.0f / gs; const int row = u.pm * BM + rl;
#pragma unroll
                for (int bj = 0; bj < 2; ++bj)
#pragma unroll
                    for (int n = 0; n < 2; ++n) { const int cl = bj * HALF + wc * 32 + n * 16 + 4 * fq; const f32x4 v = acc[ai][bj][m][n]; f32x4 p;
                        p[0] = __builtin_amdgcn_exp2f(v[0] - gm) * inv; p[1] = __builtin_amdgcn_exp2f(v[1] - gm) * inv; p[2] = __builtin_amdgcn_exp2f(v[2] - gm) * inv; p[3] = __builtin_amdgcn_exp2f(v[3] - gm) * inv;
                        st_bf4(P + ((size_t)u.pn * Mrows + row) * 256 + cl, p); } }
        (void)mx; (void)wid; (void)lane;
    }
};
template <class Epi, class Sched, bool ALIGN_EPI = false, bool SP2 = false>
__device__ __forceinline__ void gemm_phase(PG8_LAS unsigned char* lds, const Gemm g, const Sched& S, const Epi& E, const int wave_s) {
    const int lane = fresh_lane(), wid = wave_s, tid = wid * 64 + lane, wr = wid >> 2, wc = wid & 3, fr = lane & 15, fq = lane >> 4;
    const int K = g.K, nt = K / BK;
    unsigned voffA[2], voffB[2];
#pragma unroll
    for (int i = 0; i < 2; ++i) { int R, C; stage_rc(tid * 16 + i * 8192, R, C); const int Rb = Epi::PERM ? ((R & ~31) + perm32(R & 31)) : R;
        voffA[i] = (unsigned)(R * K + C) * 2u; voffB[i] = (unsigned)(Rb * K + C) * 2u; }
    const size_t kstep = (size_t)(BK * 2);
    const size_t hstep = (size_t)HALF * K * 2;
    const size_t tstep = 2 * hstep;
    const unsigned ldsw = (unsigned)wid * 1024u;
    const int aoff = lds_byte(wr * 64 + fr, fq * 8), boff = lds_byte(wc * 32 + fr, fq * 8);
#define PG8_SA(b, h) (((b) * 2 + (h)) * HTB)
#define PG8_SB(b, h) ((4 + (b) * 2 + (h)) * HTB)
#define PG8_STAGE(bufoff, gbase, voff) do { _Pragma("unroll") for (int _i = 0; _i < 2; ++_i) \
        __builtin_amdgcn_global_load_lds((const unsigned*)((const char*)(gbase) + (voff)[_i]), (PG8_LAS unsigned*)(lds + (bufoff) + ldsw + _i * 8192), 16, 0, 0); } while (0)
#define PG8_LDA(dst, b, h) do { _Pragma("unroll") for (int m = 0; m < 4; ++m) _Pragma("unroll") for (int k = 0; k < 2; ++k) dst[m][k] = *(const PG8_LAS bf16x8*)(lds + PG8_SA(b, h) + aoff + m * 2048 + k * 1024); } while (0)
#define PG8_LDB(dst, b, h) do { _Pragma("unroll") for (int n = 0; n < 2; ++n) _Pragma("unroll") for (int k = 0; k < 2; ++k) dst[n][k] = *(const PG8_LAS bf16x8*)(lds + PG8_SB(b, h) + boff + n * 2048 + k * 1024); } while (0)
#define PG8_MMA(ai, bj, At, Bt) do { __builtin_amdgcn_s_setprio(1); _Pragma("unroll") for (int m = 0; m < 4; ++m) _Pragma("unroll") for (int n = 0; n < 2; ++n) _Pragma("unroll") for (int k = 0; k < 2; ++k) \
        acc[ai][bj][m][n] = __builtin_amdgcn_mfma_f32_16x16x32_bf16(Bt[n][k], At[m][k], acc[ai][bj][m][n], 0, 0, 0); __builtin_amdgcn_s_setprio(0); } while (0)
#define PG8_WAIT_V(n) asm volatile("s_waitcnt vmcnt(" #n ")" ::: "memory")
#define PG8_WAIT_L(n) asm volatile("s_waitcnt lgkmcnt(" #n ")" ::: "memory")
#define PG8_BAR __builtin_amdgcn_s_barrier()
#define PG8_SCHED __builtin_amdgcn_sched_barrier(0)
    Unit cur, nxt; int ui = 0;
    if (!S.next(0, cur)) return;
    f32x4 acc[2][2][4][2];
#pragma unroll
    for (int a = 0; a < 2; ++a)
#pragma unroll
        for (int b = 0; b < 2; ++b)
#pragma unroll
            for (int m = 0; m < 4; ++m)
#pragma unroll
                for (int n = 0; n < 2; ++n) acc[a][b][m][n] = (f32x4){0.f, 0.f, 0.f, 0.f};
    bf16x8 At[4][2], B0[2][2], B1[2][2];
    const char* cA = S.pa(g, cur); const char* cB = S.pb(g, cur);
    S.a_ready(cur);
    if constexpr (SP2) {
        PG8_STAGE(PG8_SB(0, 0), cB, voffB); PG8_STAGE(PG8_SB(0, 1), cB + hstep, voffB); PG8_STAGE(PG8_SA(0, 0), cA, voffA); PG8_STAGE(PG8_SA(0, 1), cA + hstep, voffA);
        if (wr == 1) PG8_BAR;
        PG8_WAIT_V(2); PG8_BAR;
        PG8_STAGE(PG8_SB(1, 0), cB + kstep, voffB); PG8_STAGE(PG8_SA(1, 0), cA + kstep, voffA); PG8_STAGE(PG8_SB(1, 1), cB + hstep + kstep, voffB);
        PG8_WAIT_V(6); PG8_BAR;
    } else {
        PG8_STAGE(PG8_SB(0, 0), cB, voffB); PG8_STAGE(PG8_SA(0, 0), cA, voffA); PG8_STAGE(PG8_SB(0, 1), cB + hstep, voffB); PG8_STAGE(PG8_SA(0, 1), cA + hstep, voffA);
        if (wr == 1) PG8_BAR;
        PG8_WAIT_V(4); PG8_BAR;
        PG8_STAGE(PG8_SB(1, 0), cB + kstep, voffB); PG8_STAGE(PG8_SA(1, 0), cA + kstep, voffA); PG8_STAGE(PG8_SB(1, 1), cB + hstep + kstep, voffB);
        PG8_WAIT_V(6); PG8_BAR;
    }
    for (;;) {
        const bool has_next = S.next(ui + 1, nxt);
        const char* nA = has_next ? S.pa(g, nxt) : cA; const char* nB = has_next ? S.pb(g, nxt) : cB;
        for (int t = 0; t < nt; t += 2) {
            const bool last = (t == nt - 2);
            const char* a1 = cA + (size_t)(t + 1) * kstep;
            const char* a2 = last ? nA : cA + (size_t)(t + 2) * kstep; const char* b2 = last ? nB : cB + (size_t)(t + 2) * kstep;
            const char* a3 = a2 + kstep; const char* b3 = b2 + kstep;
            if (last && has_next) S.a_ready(nxt);
            if constexpr (SP2) {
            PG8_LDB(B0, 0, 0); PG8_LDB(B1, 0, 1); PG8_SCHED; PG8_LDA(At, 0, 0); PG8_STAGE(PG8_SA(1, 1), a1 + hstep, voffA);
            PG8_WAIT_V(8); PG8_WAIT_L(0); PG8_BAR; PG8_MMA(0, 0, At, B0); PG8_MMA(0, 1, At, B1); PG8_BAR; PG8_SCHED;
            PG8_LDA(At, 0, 1); PG8_STAGE(PG8_SB(0, 0), b2, voffB); PG8_STAGE(PG8_SB(0, 1), b2 + hstep, voffB); PG8_STAGE(PG8_SA(0, 0), a2, voffA);
            PG8_WAIT_V(8); PG8_WAIT_L(0); PG8_BAR; PG8_MMA(1, 0, At, B0); PG8_MMA(1, 1, At, B1); PG8_BAR; PG8_SCHED;
            PG8_LDB(B0, 1, 0); PG8_LDB(B1, 1, 1); PG8_SCHED; PG8_LDA(At, 1, 0); PG8_STAGE(PG8_SA(0, 1), a2 + hstep, voffA);
            PG8_WAIT_V(8); PG8_WAIT_L(0); PG8_BAR; PG8_MMA(0, 0, At, B0); PG8_MMA(0, 1, At, B1); PG8_BAR; PG8_SCHED;
            PG8_LDA(At, 1, 1); PG8_STAGE(PG8_SB(1, 0), b3, voffB); PG8_STAGE(PG8_SB(1, 1), b3 + hstep, voffB); PG8_STAGE(PG8_SA(1, 0), a3, voffA);
            PG8_WAIT_V(8); PG8_WAIT_L(0); PG8_BAR; PG8_MMA(1, 0, At, B0); PG8_MMA(1, 1, At, B1); PG8_BAR; PG8_SCHED;
            } else {
            PG8_LDB(B0, 0, 0); PG8_SCHED; PG8_LDA(At, 0, 0); PG8_STAGE(PG8_SA(1, 1), a1 + hstep, voffA);
            PG8_WAIT_L(8); PG8_BAR; PG8_WAIT_L(0); PG8_MMA(0, 0, At, B0); PG8_BAR; PG8_SCHED;
            PG8_LDB(B1, 0, 1); PG8_STAGE(PG8_SB(0, 0), b2, voffB);
            PG8_BAR; PG8_WAIT_L(0); PG8_MMA(0, 1, At, B1); PG8_BAR;
            PG8_LDA(At, 0, 1); PG8_STAGE(PG8_SA(0, 0), a2, voffA);
            PG8_BAR; PG8_WAIT_L(0); PG8_MMA(1, 0, At, B0); PG8_BAR; PG8_SCHED;
            PG8_STAGE(PG8_SB(0, 1), b2 + hstep, voffB);
            PG8_WAIT_V(6); PG8_BAR; PG8_MMA(1, 1, At, B1); PG8_BAR;
            PG8_LDB(B0, 1, 0); PG8_SCHED; PG8_LDA(At, 1, 0); PG8_STAGE(PG8_SA(0, 1), a2 + hstep, voffA);
            PG8_WAIT_L(8); PG8_BAR; PG8_WAIT_L(0); PG8_MMA(0, 0, At, B0); PG8_BAR; PG8_SCHED;
            PG8_LDB(B1, 1, 1); PG8_STAGE(PG8_SB(1, 0), b3, voffB);
            PG8_BAR; PG8_WAIT_L(0); PG8_MMA(0, 1, At, B1); PG8_BAR;
            PG8_LDA(At, 1, 1); PG8_STAGE(PG8_SA(1, 0), a3, voffA);
            PG8_BAR; PG8_WAIT_L(0); PG8_MMA(1, 0, At, B0); PG8_BAR; PG8_SCHED;
            PG8_STAGE(PG8_SB(1, 1), b3 + hstep, voffB);
            PG8_WAIT_V(6); PG8_BAR; PG8_MMA(1, 1, At, B1); PG8_BAR;
            }
        }
        if constexpr (ALIGN_EPI) { if (wr == 0) PG8_BAR; }
        if constexpr (!Epi::AFTER_DRAIN) { E(acc, cur, wr, wc, fr, fq); S.done(cur); }
        if (!has_next) break;
#pragma unroll
        for (int a = 0; a < 2; ++a)
#pragma unroll
            for (int b = 0; b < 2; ++b)
#pragma unroll
                for (int m = 0; m < 4; ++m)
#pragma unroll
                    for (int n = 0; n < 2; ++n) acc[a][b][m][n] = (f32x4){0.f, 0.f, 0.f, 0.f};
        cur = nxt; cA = nA; cB = nB; ++ui;
        if constexpr (ALIGN_EPI) { if (wr == 1) PG8_BAR; }
    }
    PG8_WAIT_V(0);
    if constexpr (!ALIGN_EPI) { if (wr == 0) PG8_BAR; }
    PG8_BAR;
    if constexpr (Epi::AFTER_DRAIN) { E.fused(acc, cur, wr, wc, fr, fq, lds, wid, lane); S.done(cur); }
#undef PG8_SA
#undef PG8_SB
#undef PG8_STAGE
#undef PG8_LDA
#undef PG8_LDB
#undef PG8_MMA
#undef PG8_WAIT_V
#undef PG8_WAIT_L
#undef PG8_BAR
#undef PG8_SCHED
}
}

constexpr int NW = 8, NT = NW * 64;
constexpr int BATCH = 2, SEQ = 8192, D = 1024, M = BATCH * SEQ, DFF = 2816, NH = 8, DH = 128, MEMLEN = 256, MROWS = BATCH * MEMLEN;
constexpr int IN_COLS = 9224;
constexpr float EPS = 1e-6f, LOG2E = 1.4426950408889634f;
constexpr int LDS_BYTES = 147456, RING_BYTES = 131072, MISC_OFF = RING_BYTES;
constexpr int NPHASE = 16;
#ifndef ONE_LAUNCH
#define ONE_LAUNCH 0
#endif

constexpr size_t MiB = 1u << 20;
constexpr size_t WS_CTL = 0, CTL_ZERO_BYTES = 65536;
constexpr int CW_BAR = 4096;
constexpr size_t WS_WF = 1 * MiB;
constexpr size_t WS_LC = 1 * MiB + 64 * 1024;
constexpr size_t WS_BT = 1 * MiB + 640 * 1024;
constexpr size_t WS_RSTD = 1 * MiB + 704 * 1024;
constexpr size_t WS_SSQ = 2 * MiB;
constexpr size_t WS_MEMN = 4 * MiB;
constexpr size_t WS_KM = 5 * MiB;
constexpr size_t WS_VTM = 6 * MiB;
constexpr size_t WS_W1A = 8 * MiB, WS_W1D = WS_W1A + 11 * MiB, WS_WIN = WS_W1D + 11 * MiB / 2, WS_WBA = WS_WIN + 18 * MiB, WS_WBB = WS_WBA + 2 * MiB, WS_WOUT = WS_WBB + 2 * MiB,
                 WS_WMQ = WS_WOUT + 2 * MiB, WS_WMO = WS_WMQ + 2 * MiB, WS_WMKV = WS_WMO + 2 * MiB, WS_W2A = WS_WMKV + 4 * MiB, WS_W2D = WS_W2A + 11 * MiB, WS_WEND = WS_W2D + 11 * MiB / 2;
static_assert(WS_WEND == 73 * MiB, "weights map");
constexpr size_t WS_XN = 74 * MiB;
constexpr size_t WS_R = 106 * MiB;
constexpr size_t WS_HID = WS_R;
constexpr size_t WS_QA = WS_R, WS_LF = WS_R + 32 * MiB, WS_IT = WS_R + 64 * MiB, WS_VT = WS_R + 96 * MiB;
constexpr size_t WS_Y = WS_R, WS_QMH = WS_R + 32 * MiB, WS_P = WS_R + 64 * MiB, WS_OM = WS_R + 96 * MiB;
constexpr size_t WS_END = 256 * MiB;
constexpr size_t GB_Z = 0, GB_GA = 0, GB_QB = 32 * MiB, GB_KB = 64 * MiB, GB_GT = 96 * MiB, GB_BYTES = 160 * MiB;
__device__ __attribute__((aligned(256))) unsigned char g_buf[GB_BYTES];

#define LAS __attribute__((address_space(3)))
typedef unsigned short bf16;
typedef unsigned v4u __attribute__((ext_vector_type(4)));
typedef unsigned v2u __attribute__((ext_vector_type(2)));
typedef float f32x4 __attribute__((ext_vector_type(4)));
typedef float f32x16 __attribute__((ext_vector_type(16)));
typedef short bf16x8 __attribute__((ext_vector_type(8)));
__device__ __forceinline__ unsigned f2bf(float f) { unsigned u = __builtin_bit_cast(unsigned, f); return (u + 0x7fffu + ((u >> 16) & 1u)) >> 16; }
__device__ __forceinline__ unsigned pk2(float lo, float hi) { return f2bf(lo) | (f2bf(hi) << 16); }
__device__ __forceinline__ float bf2f(unsigned v) { return __builtin_bit_cast(float, v << 16); }
__device__ __forceinline__ float wave_sum(float v) {
#pragma unroll
    for (int o = 1; o < 64; o <<= 1) v += __shfl_xor(v, o);
    return v;
}
#define MFMA32(a, b, c) __builtin_amdgcn_mfma_f32_32x32x16_bf16((a), (b), (c), 0, 0, 0)
__device__ __forceinline__ int crow(int reg, int h) { return (reg & 3) + 8 * (reg >> 2) + 4 * h; }
__device__ __forceinline__ int prow(int m) { return (m & 0x13) | ((m & 4) << 1) | ((m & 8) >> 1); }
__device__ __forceinline__ bf16x8 pack8(const f32x16& x, int s) {
    v4u p; p.x = pk2(x[8 * s + 0], x[8 * s + 1]); p.y = pk2(x[8 * s + 2], x[8 * s + 3]); p.z = pk2(x[8 * s + 4], x[8 * s + 5]); p.w = pk2(x[8 * s + 6], x[8 * s + 7]);
    return __builtin_bit_cast(bf16x8, p);
}

struct Ptrs {
    const float *x, *mem, *f1g, *f1wi, *f1wd, *f1pg, *mixg, *win, *lbl, *hgg, *fbias, *wba, *wbb, *bgate, *wout, *mixpg, *mempg, *memkvg, *wmq, *wmkv, *wmo, *mempostg, *f2g, *f2wi, *f2wd, *f2pg;
    float* out; unsigned char* ws; int ph_lo, ph_hi;
};

__device__ __forceinline__ void transpose_item(const float* W, int K, int N, bf16* WT, int kb, int n_src, int n_dst, LAS float* scr, int lane) {
    const int k0 = 64 * kb;
#pragma unroll 8
    for (int i = 0; i < 32; ++i) { const int kk = 2 * i + (lane >> 5); scr[kk * 33 + (lane & 31)] = W[(size_t)(k0 + kk) * N + n_src + (lane & 31)]; }
    asm volatile("s_waitcnt lgkmcnt(0)" ::: "memory");
    const int c = lane & 7;
#pragma unroll
    for (int j = 0; j < 4; ++j) { const int n = (lane >> 3) + 8 * j; const LAS float* s = scr + (8 * c) * 33 + n;
        v4u o; o.x = pk2(s[0 * 33], s[1 * 33]); o.y = pk2(s[2 * 33], s[3 * 33]); o.z = pk2(s[4 * 33], s[5 * 33]); o.w = pk2(s[6 * 33], s[7 * 33]);
        *(v4u*)(WT + (size_t)(n_dst + n) * K + k0 + 8 * c) = o; }
    asm volatile("s_waitcnt lgkmcnt(0)" ::: "memory");
}
__device__ __forceinline__ void rms_row_to_bf16(const float* xrow, const float* g, bf16* orow, int lane) {
    const f32x4* xr = (const f32x4*)xrow + lane; const f32x4* gr = (const f32x4*)g + lane;
    f32x4 v[4]; float s = 0.f;
#pragma unroll
    for (int j = 0; j < 4; ++j) { v[j] = xr[64 * j]; s += (v[j][0] * v[j][0] + v[j][1] * v[j][1]) + (v[j][2] * v[j][2] + v[j][3] * v[j][3]); }
    const float rs = 1.0f / sqrtf(wave_sum(s) * (1.0f / D) + EPS);
    v2u* o8 = (v2u*)orow + lane;
#pragma unroll
    for (int j = 0; j < 4; ++j) { const f32x4 gg = gr[64 * j]; v2u w; w.x = pk2(v[j][0] * rs * gg[0], v[j][1] * rs * gg[1]); w.y = pk2(v[j][2] * rs * gg[2], v[j][3] * rs * gg[3]); o8[64 * j] = w; }
}

struct TItem { const float* W; int K, N; bf16* WT; int nblk; int kind; };
typedef const __attribute__((address_space(4))) Ptrs* KPtr0;
__device__ __forceinline__ void p0_prologue(KPtr0 KP, LAS unsigned char* lds, int wave) {
#define P (*KP)
    const int lane = fresh_lane();
    unsigned char* ws = P.ws;
    LAS float* scr = (LAS float*)(lds + wave * 16384);
    const int gw = blockIdx.x * NW + wave, NGW = gridDim.x * NW;
    constexpr int I_1A = 16 * 176, I_1D = 44 * 32, I_IN = 16 * 288, I_SQ = 16 * 32, I_KV = 16 * 64;
    constexpr int NITEMS = 2 * I_1A + 2 * I_1D + I_IN + 5 * I_SQ + I_KV;
    for (int it = gw; it < NITEMS; it += NGW) {
        int r = it; const float* W; int K, N, kind; bf16* WT;
        if (r < I_1A) { W = P.f1wi; K = D; N = 2 * DFF; WT = (bf16*)(ws + WS_W1A); kind = 1; }
        else if ((r -= I_1A) < I_1A) { W = P.f2wi; K = D; N = 2 * DFF; WT = (bf16*)(ws + WS_W2A); kind = 1; }
        else if ((r -= I_1A) < I_1D) { W = P.f1wd; K = DFF; N = D; WT = (bf16*)(ws + WS_W1D); kind = 0; }
        else if ((r -= I_1D) < I_1D) { W = P.f2wd; K = DFF; N = D; WT = (bf16*)(ws + WS_W2D); kind = 0; }
        else if ((r -= I_1D) < I_IN) { W = P.win; K = D; N = IN_COLS; WT = (bf16*)(ws + WS_WIN); kind = 2; }
        else if ((r -= I_IN) < I_SQ) { W = P.wba; K = D; N = D; WT = (bf16*)(ws + WS_WBA); kind = 0; }
        else if ((r -= I_SQ) < I_SQ) { W = P.wbb; K = D; N = D; WT = (bf16*)(ws + WS_WBB); kind = 0; }
        else if ((r -= I_SQ) < I_SQ) { W = P.wout; K = D; N = D; WT = (bf16*)(ws + WS_WOUT); kind = 0; }
        else if ((r -= I_SQ) < I_SQ) { W = P.wmq; K = D; N = D; WT = (bf16*)(ws + WS_WMQ); kind = 0; }
        else if ((r -= I_SQ) < I_SQ) { W = P.wmo; K = D; N = D; WT = (bf16*)(ws + WS_WMO); kind = 0; }
        else { r -= I_SQ; W = P.wmkv; K = D; N = 2 * D; WT = (bf16*)(ws + WS_WMKV); kind = 0; }
        int ndb = (kind == 2) ? 288 : N / 32;
        const int kb = r / ndb, nb = r % ndb; const int n_dst = 32 * nb; int n_src = n_dst;
        if (kind == 1) { const int tile = n_dst >> 8, w = n_dst & 255; n_src = (w < 128) ? (tile * 128 + w) : (DFF + tile * 128 + (w - 128)); }
        else if (kind == 2) {
            const int seg = n_dst >> 10, w = n_dst & 1023;
            const int srcbase = (seg == 0) ? 0 : (seg == 1) ? 1024 : (seg == 2) ? 3072 : (seg == 3) ? 4096 : (seg == 4) ? 5120 : (seg == 5) ? 7176 : (seg == 6) ? 8200 : (seg == 7) ? 2048 : 6144;
            n_src = srcbase + w; }
        transpose_item(W, K, N, WT, kb, n_src, n_dst, scr, lane);
    }
    { float* WF = (float*)(ws + WS_WF); const int gt = blockIdx.x * NT + wave * 64 + lane; if (gt < 8 * 1024) { const int j = gt >> 10, k = gt & 1023; WF[gt] = P.win[(size_t)k * IN_COLS + 7168 + j]; } }
    bf16* XN = (bf16*)(ws + WS_XN); bf16* MEMN = (bf16*)(ws + WS_MEMN);
    for (int m = gw; m < M; m += NGW) rms_row_to_bf16(P.x + (size_t)m * D, P.f1g, XN + (size_t)m * D, lane);
    for (int m = gw; m < MROWS; m += NGW) rms_row_to_bf16(P.mem + (size_t)m * D, P.memkvg, MEMN + (size_t)m * D, lane);
#undef P
}

template <bool HAS_XN, bool FB>
__device__ __forceinline__ void rowpass(const float* xin, const float* Z, const float* gpost, float coef, float* xout, const float* gpre, bf16* XN,
                                        const float* WF, const float* fbias, float* LC, float* BT, LAS unsigned char* lds, int wave) {
    const int lane = fresh_lane(), tid = wave * 64 + lane;
    LAS float* lsf = (LAS float*)lds;
    for (int blk = blockIdx.x; blk < M / 64; blk += gridDim.x) {
        for (int rr = 0; rr < 8; ++rr) {
            const int rl = wave * 8 + rr; const size_t row = (size_t)blk * 64 + rl;
            const f32x4* zr = (const f32x4*)(Z + row * D) + lane; const f32x4* xr = (const f32x4*)(xin + row * D) + lane; f32x4* xo = (f32x4*)(xout + row * D) + lane;
            f32x4 z[4], xv[4]; float s = 0.f;
#pragma unroll
            for (int j = 0; j < 4; ++j) { z[j] = zr[64 * j]; xv[j] = xr[64 * j]; s += (z[j][0] * z[j][0] + z[j][1] * z[j][1]) + (z[j][2] * z[j][2] + z[j][3] * z[j][3]); }
            const float rs = coef / sqrtf(wave_sum(s) * (1.0f / D) + EPS); float s2 = 0.f;
#pragma unroll
            for (int j = 0; j < 4; ++j) { const f32x4 gg = ((const f32x4*)gpost + lane)[64 * j]; xv[j] = xv[j] + z[j] * gg * rs; xo[64 * j] = xv[j];
                s2 += (xv[j][0] * xv[j][0] + xv[j][1] * xv[j][1]) + (xv[j][2] * xv[j][2] + xv[j][3] * xv[j][3]); }
            if (HAS_XN) {
                const float rs2 = 1.0f / sqrtf(wave_sum(s2) * (1.0f / D) + EPS);
                v2u* o8 = (v2u*)(XN + row * D) + lane;
#pragma unroll
                for (int j = 0; j < 4; ++j) { const f32x4 gg = ((const f32x4*)gpre + lane)[64 * j]; xv[j] = xv[j] * gg * rs2; v2u w; w.x = pk2(xv[j][0], xv[j][1]); w.y = pk2(xv[j][2], xv[j][3]); o8[64 * j] = w; }
                if (FB) {
#pragma unroll
                    for (int h = 0; h < 8; ++h) { float d = 0.f;
#pragma unroll
                        for (int j = 0; j < 4; ++j) { const f32x4 w = ((const f32x4*)(WF + h * 1024) + lane)[64 * j]; d += (xv[j][0] * w[0] + xv[j][1] * w[1]) + (xv[j][2] * w[2] + xv[j][3] * w[3]); }
                        d = wave_sum(d) + fbias[h];
                        const float ls = fminf(d, 0.f) - log1pf(__expf(-fabsf(d)));
                        if (lane == 0) lsf[rl * 8 + h] = ls; }
                }
            }
        }
        if (FB) {
            __syncthreads();
            if (tid < 8) { const int h = tid; float run = 0.f;
                for (int r = 0; r < 64; ++r) { run += lsf[r * 8 + h]; LC[((size_t)blk * 64 + r) * 8 + h] = run; }
                BT[blk * 8 + h] = run; }
            __syncthreads();
        }
    }
}

namespace fox {
constexpr int KSTR = 272, VSTR = 144, KBYTES = 64 * KSTR, VBYTES = 128 * VSTR, BUFB = KBYTES + VBYTES, CK_OFF = 2 * BUFB, CPRE_OFF = CK_OFF + 512;
static_assert(CPRE_OFF + 512 <= RING_BYTES, "fox lds");
__device__ __forceinline__ void unit(LAS unsigned char* lds, int u, bf16* QB, const bf16* KB, const bf16* VT, const float* LC, const float* BT, int wave) {
    const int lane = fresh_lane(), tid = wave * 64 + lane;
    const int bh = u & 15, qblk = 31 - (u >> 4), b = bh >> 3, h = bh & 7;
    const int half = lane >> 5, l31 = lane & 31;
    LAS float* ck = (LAS float*)(lds + CK_OFF); LAS float* cpre = (LAS float*)(lds + CPRE_OFF);
    if (tid < 128) { float s = 0.f; for (int j = 0; j < tid; ++j) s += BT[(b * 128 + j) * 8 + h]; cpre[tid] = s; }
    const int qs = qblk * 256 + 32 * wave + l31;
    const size_t qtok = (size_t)b * SEQ + qs;
    bf16x8 qf[8];
#pragma unroll
    for (int ks = 0; ks < 8; ++ks) qf[ks] = *(const bf16x8*)(QB + qtok * 1024 + h * 128 + 16 * ks + 8 * half);
    __syncthreads();
    const float cq = (LC[qtok * 8 + h] + cpre[qs >> 6]) * LOG2E;
    const int ntiles = 4 * (qblk + 1);
    v4u kr[2], vr[2]; float ckr = 0.f;
    const int krow_[2] = {tid >> 4, (tid + 512) >> 4}, kc16 = tid & 15;
    const int vrow_[2] = {tid >> 3, (tid + 512) >> 3}, vc16 = tid & 7;
#define FOX_LOAD(t) do { const size_t k0 = (size_t)b * SEQ + 64 * (t); \
        _Pragma("unroll") for (int i = 0; i < 2; ++i) { kr[i] = *(const v4u*)(KB + (k0 + krow_[i]) * 1024 + h * 128 + 8 * kc16); vr[i] = *(const v4u*)(VT + (size_t)(h * 128 + vrow_[i]) * M + k0 + 8 * vc16); } \
        if (tid < 64) ckr = (LC[(k0 + tid) * 8 + h] + cpre[(t)]) * LOG2E; } while (0)
#define FOX_STORE(buf) do { LAS unsigned char* Kl = lds + (buf) * BUFB; LAS unsigned char* Vl = Kl + KBYTES; \
        _Pragma("unroll") for (int i = 0; i < 2; ++i) { *(LAS v4u*)(Kl + krow_[i] * KSTR + 16 * kc16) = kr[i]; *(LAS v4u*)(Vl + vrow_[i] * VSTR + 16 * vc16) = vr[i]; } \
        if (tid < 64) ck[(buf) * 64 + tid] = ckr; } while (0)
    FOX_LOAD(0); FOX_STORE(0);
    __syncthreads();
    f32x16 o[4];
#pragma unroll
    for (int rb = 0; rb < 4; ++rb)
#pragma unroll
        for (int i = 0; i < 16; ++i) o[rb][i] = 0.f;
    float mrun = -INFINITY, lrun = 0.f;
    const int qmin = qblk * 256 + 32 * wave;
    const int kperm = prow(l31);
    for (int t = 0; t < ntiles; ++t) {
        const int buf = t & 1;
        if (t + 1 < ntiles) FOX_LOAD(t + 1);
        const int kpos0 = 64 * t;
        if (kpos0 <= qmin + 31) {
            const bool full = (kpos0 + 63 <= qmin);
            LAS unsigned char* Kl = lds + buf * BUFB; LAS unsigned char* Vl = Kl + KBYTES;
            f32x16 s[2];
#pragma unroll
            for (int blk = 0; blk < 2; ++blk) {
#pragma unroll
                for (int i = 0; i < 16; ++i) s[blk][i] = 0.f;
#pragma unroll
                for (int ks = 0; ks < 8; ++ks) { const bf16x8 a = *(const LAS bf16x8*)(Kl + (32 * blk + kperm) * KSTR + 32 * ks + 16 * half); s[blk] = MFMA32(a, qf[ks], s[blk]); }
            }
            float mx = -INFINITY;
#pragma unroll
            for (int blk = 0; blk < 2; ++blk)
#pragma unroll
                for (int g = 0; g < 2; ++g) { const int key0 = 32 * blk + 16 * g + 8 * half; const f32x4 c0 = *(const LAS f32x4*)(ck + buf * 64 + key0), c1 = *(const LAS f32x4*)(ck + buf * 64 + key0 + 4);
#pragma unroll
                    for (int e = 0; e < 8; ++e) { const int i = 8 * g + e; float sc = s[blk][i] + (cq - (e < 4 ? c0[e & 3] : c1[e & 3]));
                        if (!full && (kpos0 + key0 + e > qs)) sc = -INFINITY;
                        s[blk][i] = sc; mx = fmaxf(mx, sc); } }
            mx = fmaxf(mx, __shfl_xor(mx, 32));
            const float mnew = fmaxf(mrun, mx), alpha = __builtin_amdgcn_exp2f(mrun - mnew); mrun = mnew;
            float ps = 0.f;
#pragma unroll
            for (int blk = 0; blk < 2; ++blk)
#pragma unroll
                for (int i = 0; i < 16; ++i) { const float p = __builtin_amdgcn_exp2f(s[blk][i] - mnew); s[blk][i] = p; ps += p; }
            lrun = lrun * alpha + ps;
#pragma unroll
            for (int rb = 0; rb < 4; ++rb)
#pragma unroll
                for (int i = 0; i < 16; ++i) o[rb][i] *= alpha;
            bf16x8 pf[4];
#pragma unroll
            for (int k4 = 0; k4 < 4; ++k4) pf[k4] = pack8(s[k4 >> 1], k4 & 1);
#pragma unroll
            for (int rb = 0; rb < 4; ++rb)
#pragma unroll
                for (int k4 = 0; k4 < 4; ++k4) { const bf16x8 a = *(const LAS bf16x8*)(Vl + (32 * rb + l31) * VSTR + 32 * k4 + 16 * half); o[rb] = MFMA32(a, pf[k4], o[rb]); }
        }
        if (t + 1 < ntiles) FOX_STORE(buf ^ 1);
        __syncthreads();
    }
    const float ltot = lrun + __shfl_xor(lrun, 32), inv = 1.0f / ltot;
    bf16* orow = QB + qtok * 1024 + h * 128;
#pragma unroll
    for (int rb = 0; rb < 4; ++rb)
#pragma unroll
        for (int g = 0; g < 4; ++g) { v2u w; w.x = pk2(o[rb][4 * g] * inv, o[rb][4 * g + 1] * inv); w.y = pk2(o[rb][4 * g + 2] * inv, o[rb][4 * g + 3] * inv);
            *(v2u*)(orow + 32 * rb + 8 * g + 4 * half) = w; }
#undef FOX_LOAD
#undef FOX_STORE
}
}

namespace hg {
constexpr int RS = 272;
constexpr int QH_OFF = 0, QE_OFF = 64 * RS, KH_OFF = 2 * 64 * RS, KHT_OFF = 3 * 64 * RS, KHT_RS = 144, ST_OFF = KHT_OFF + 128 * KHT_RS, ST_BYTES = 32 * RS,
              GT_OFF = ST_OFF + 2 * ST_BYTES, D1_OFF = GT_OFF + 2048, D2_OFF = D1_OFF + 512, END_OFF = D2_OFF + 512;
static_assert(END_OFF <= RING_BYTES, "hgrn lds");
__device__ __forceinline__ void unit(LAS unsigned char* lds, int u, const bf16* QA, const bf16* LF, const bf16* IT, bf16* GA, const float* hgg, float* SSQ, int wave) {
    const int lane = fresh_lane(), tid = wave * 64 + lane;
    const int b = u >> 5, h = (u >> 2) & 7, vs = u & 3;
    const int half = lane >> 5, l31 = lane & 31;
    const int c = tid & 127, tg = tid >> 7;
    const size_t tok0 = (size_t)b * SEQ;
    LAS float* GTOT = (LAS float*)(lds + GT_OFF); LAS float* D1 = (LAS float*)(lds + D1_OFF); LAS float* D2 = (LAS float*)(lds + D2_OFF);
    for (int i = tid; i < ST_BYTES / 4; i += NT) ((LAS unsigned*)(lds + ST_OFF))[i] = 0u;
    f32x16 S;
#pragma unroll
    for (int i = 0; i < 16; ++i) S[i] = 0.f;
    unsigned short lfr[16], qr[16]; bf16x8 itf[4];
    const bf16* itrow = IT + (size_t)(h * 128 + 32 * vs + l31) * M + tok0 + 8 * half;
#define HG_LOAD(n) do { const size_t t0 = tok0 + 64 * (n) + 16 * tg; \
        _Pragma("unroll") for (int k = 0; k < 16; ++k) { lfr[k] = LF[(t0 + k) * 1024 + h * 128 + c]; qr[k] = QA[(t0 + k) * 1024 + h * 128 + c]; } \
        if (wave < 6) { _Pragma("unroll") for (int ks = 0; ks < 4; ++ks) itf[ks] = *(const bf16x8*)(itrow + 64 * (n) + 16 * ks); } } while (0)
    HG_LOAD(0);
    __syncthreads();
    for (int n = 0; n < SEQ / 64; ++n) {
        float lf[16], bl[16], qv[16]; float run = 0.f;
#pragma unroll
        for (int k = 0; k < 16; ++k) { lf[k] = bf2f(lfr[k]); qv[k] = bf2f(qr[k]); run += lf[k]; bl[k] = run; }
        bf16x8 itc[4];
#pragma unroll
        for (int ks = 0; ks < 4; ++ks) itc[ks] = itf[ks];
        GTOT[tg * 128 + c] = run;
        if (n + 1 < SEQ / 64) HG_LOAD(n + 1);
        __syncthreads();
        const float g0 = GTOT[c], g1 = GTOT[128 + c], g2 = GTOT[256 + c], g3 = GTOT[384 + c];
        const float off = (tg > 0 ? g0 : 0.f) + (tg > 1 ? g1 : 0.f) + (tg > 2 ? g2 : 0.f);
        const float b31 = g0 + g1, b63 = b31 + g2 + g3;
        unsigned kt[8];
#pragma unroll
        for (int k = 0; k < 16; ++k) { const int t = 16 * tg + k; const float bb = off + bl[k], bp = bb - b31;
            const float qh = qv[k] * __expf(bp), qe = qv[k] * __expf(bb), kk = (1.0f - __expf(lf[k])) * __expf(-bp);
            *(LAS unsigned short*)(lds + QH_OFF + t * RS + 2 * c) = (unsigned short)f2bf(qh);
            *(LAS unsigned short*)(lds + QE_OFF + t * RS + 2 * c) = (unsigned short)f2bf(qe);
            const unsigned kb = f2bf(kk);
            *(LAS unsigned short*)(lds + KH_OFF + t * RS + 2 * c) = (unsigned short)kb;
            if (k & 1) kt[k >> 1] |= kb << 16; else kt[k >> 1] = kb; }
        *(LAS v4u*)(lds + KHT_OFF + c * KHT_RS + 32 * tg) = (v4u){kt[0], kt[1], kt[2], kt[3]};
        *(LAS v4u*)(lds + KHT_OFF + c * KHT_RS + 32 * tg + 16) = (v4u){kt[4], kt[5], kt[6], kt[7]};
        if (tg == 0) { D1[c] = __expf(b31); D2[c] = __expf(b63 - b31); }
        __syncthreads();
        LAS unsigned char* STc = lds + ST_OFF + (n & 1) * ST_BYTES; LAS unsigned char* STn = lds + ST_OFF + ((n + 1) & 1) * ST_BYTES;
        if (wave < 4) {
            const int cc = 32 * wave + l31; const float d1 = D1[cc], d2 = D2[cc];
            f32x16 acc;
#pragma unroll
            for (int i = 0; i < 16; ++i) acc[i] = S[i] * d1;
#pragma unroll
            for (int ks = 0; ks < 4; ++ks) { const bf16x8 bq = *(const LAS bf16x8*)(lds + KHT_OFF + cc * KHT_RS + 32 * ks + 16 * half); acc = MFMA32(itc[ks], bq, acc); }
#pragma unroll
            for (int i = 0; i < 16; ++i) { S[i] = acc[i] * d2; *(LAS unsigned short*)(STn + crow(i, half) * RS + 2 * cc) = (unsigned short)f2bf(S[i]); }
        } else if (wave < 6) {
            const int tb = wave - 4, t = 32 * tb + l31;
            f32x16 o;
#pragma unroll
            for (int i = 0; i < 16; ++i) o[i] = 0.f;
            {
#pragma unroll
                for (int ks = 0; ks < 8; ++ks) { const bf16x8 a = *(const LAS bf16x8*)(STc + l31 * RS + 32 * ks + 16 * half); const bf16x8 bq = *(const LAS bf16x8*)(lds + QE_OFF + t * RS + 32 * ks + 16 * half); o = MFMA32(a, bq, o); }
            }
            bf16x8 qhf[8];
#pragma unroll
            for (int ks = 0; ks < 8; ++ks) qhf[ks] = *(const LAS bf16x8*)(lds + QH_OFF + t * RS + 32 * ks + 16 * half);
            const int kp = prow(l31);
            for (int sb = 0; sb <= tb; ++sb) {
                f32x16 am;
#pragma unroll
                for (int i = 0; i < 16; ++i) am[i] = 0.f;
#pragma unroll
                for (int ks = 0; ks < 8; ++ks) { const bf16x8 a = *(const LAS bf16x8*)(lds + KH_OFF + (32 * sb + kp) * RS + 32 * ks + 16 * half); am = MFMA32(a, qhf[ks], am); }
                if (sb == tb) {
#pragma unroll
                    for (int i = 0; i < 16; ++i) { const int s = 16 * (i >> 3) + 8 * half + (i & 7); if (s > l31) am[i] = 0.f; }
                }
                const bf16x8 p0 = pack8(am, 0), p1 = pack8(am, 1);
                if (sb == 0) { o = MFMA32(itc[0], p0, o); o = MFMA32(itc[1], p1, o); } else { o = MFMA32(itc[2], p0, o); o = MFMA32(itc[3], p1, o); }
            }
            const size_t tok = tok0 + 64 * n + t; float ssq = 0.f;
            bf16* gp = GA + tok * 1024 + h * 128 + 32 * vs;
#pragma unroll
            for (int g = 0; g < 4; ++g) { const int v0 = 8 * g + 4 * half; const v2u gw = *(const v2u*)(gp + v0); const f32x4 gn = *(const f32x4*)(hgg + h * 128 + 32 * vs + v0);
                const float a0 = o[4 * g], a1 = o[4 * g + 1], a2 = o[4 * g + 2], a3 = o[4 * g + 3]; ssq += (a0 * a0 + a1 * a1) + (a2 * a2 + a3 * a3);
                v2u w; w.x = pk2(a0 * gn[0] * bf2f(gw.x & 0xffffu), a1 * gn[1] * bf2f(gw.x >> 16)); w.y = pk2(a2 * gn[2] * bf2f(gw.y & 0xffffu), a3 * gn[3] * bf2f(gw.y >> 16));
                *(v2u*)(gp + v0) = w; }
            ssq += __shfl_xor(ssq, 32);
            if (half == 0) SSQ[tok * 32 + h * 4 + vs] = ssq;
        }
        __syncthreads();
    }
#undef HG_LOAD
}
}

#define XB_TMO      128
#define XB_XCNT(j)  (256  + 64 * (j))
#define XB_XSUB(j)  (1280 + 64 * (j))
#define XB_XGEN(j)  (2304 + 64 * (j))
#define XB_TOP      3328
#define XB_TOPGEN   3392
#define XCD_BAR_WORDS 3456
#define XB_SPIN_CAP (1u << 18)

__device__ __forceinline__ unsigned xb_ld(unsigned* p)              { return __hip_atomic_load(p, __ATOMIC_RELAXED, __HIP_MEMORY_SCOPE_AGENT); }
__device__ __forceinline__ unsigned xb_add(unsigned* p, unsigned v) { return __hip_atomic_fetch_add(p, v, __ATOMIC_RELAXED, __HIP_MEMORY_SCOPE_AGENT); }
__device__ __forceinline__ unsigned xb_xcc_id() { return (unsigned)__builtin_amdgcn_s_getreg((3 << 11) | 20) & 0xFu; }
#define XB_SPIN(cond, bar) do { unsigned _sp = 0; while (cond) { __builtin_amdgcn_s_sleep(1); \
    if ((++_sp & 255u) == 0u) { if (xb_ld(&(bar)[XB_TMO])) break; if (_sp > XB_SPIN_CAP) { atomicAdd(&(bar)[XB_TMO], 1u); break; } } } } while (0)

struct XcdBarrier {
    unsigned* bar; unsigned x;
    volatile LAS unsigned* st;
};

__device__ __forceinline__ XcdBarrier xcd_barrier_post(unsigned* bar, volatile LAS unsigned* st, int tid) {
    XcdBarrier b; b.bar = bar; b.x = xb_xcc_id(); b.st = st;
    if (tid == 0) (void)xb_add(&bar[XB_XCNT(b.x)], 1u);
    return b;
}
__device__ __forceinline__ void xcd_barrier_complete(unsigned* bar, unsigned x, unsigned& nloc, unsigned& nx) {
    const unsigned G = gridDim.x * gridDim.y * gridDim.z;
    unsigned sum, cnt, mine, sp = 0u;
    for (;;) {
        sum = 0u; cnt = 0u; mine = 0u;
#pragma unroll
        for (unsigned j = 0; j < 16; ++j) { const unsigned c = xb_ld(&bar[XB_XCNT(j)]); sum += c; cnt += (c > 0u) ? 1u : 0u; mine = (j == x) ? c : mine; }
        if (sum == G) break;
        __builtin_amdgcn_s_sleep(1);
        if ((++sp & 255u) == 0u) { if (xb_ld(&bar[XB_TMO])) break; if (sp > XB_SPIN_CAP) { atomicAdd(&bar[XB_TMO], 1u); break; } }
    }
    nloc = mine > 0u ? mine : 1u; nx = cnt > 0u ? cnt : 1u;
}

__device__ __forceinline__ void xcd_barrier(const XcdBarrier& b, int tid) {
    asm volatile("s_waitcnt vmcnt(0)" ::: "memory");
    __syncthreads();
    if (tid == 0) {
        unsigned* bar = b.bar;
        __builtin_amdgcn_s_waitcnt(0);
        unsigned nloc = b.st[0], nx = b.st[1];
        if (nloc == 0u) { xcd_barrier_complete(bar, b.x, nloc, nx); b.st[0] = nloc; b.st[1] = nx; }
        const unsigned old = xb_add(&bar[XB_XSUB(b.x)], 1u);
        const unsigned gen = old / nloc;
        if (old + 1u == (gen + 1u) * nloc) {
            __builtin_amdgcn_fence(__ATOMIC_RELEASE, "agent");
            asm volatile("s_waitcnt vmcnt(0)" ::: "memory");
            const unsigned og = xb_add(&bar[XB_TOP], 1u);
            const unsigned tg = og / nx;
            if (og + 1u == (tg + 1u) * nx) xb_add(&bar[XB_TOPGEN], 1u);
            else XB_SPIN(xb_ld(&bar[XB_TOPGEN]) == tg, bar);
            __builtin_amdgcn_fence(__ATOMIC_ACQUIRE, "agent");
            xb_add(&bar[XB_XGEN(b.x)], 1u);
            asm volatile("s_waitcnt vmcnt(0)" ::: "memory");
        } else {
            XB_SPIN(xb_ld(&bar[XB_XGEN(b.x)]) == gen, bar);
            __builtin_amdgcn_fence(__ATOMIC_ACQUIRE, "agent");
            asm volatile("s_waitcnt vmcnt(0)" ::: "memory");
        }
    }
    __syncthreads();
}

typedef const __attribute__((address_space(4))) Ptrs* KPtr;
__global__ void __launch_bounds__(NT, 2) fwd(Ptrs P_unused) {
    KPtr KP = (KPtr)__builtin_amdgcn_kernarg_segment_ptr();
#define P (*KP)
    extern __shared__ __attribute__((aligned(16))) unsigned char lds_raw[];
    LAS unsigned char* lds = (LAS unsigned char*)lds_raw;
    const int wave = __builtin_amdgcn_readfirstlane((int)threadIdx.x >> 6);
#define IDS const int lane = fresh_lane(); const int tid = wave * 64 + lane; (void)tid; (void)lane
    const int G = gridDim.x, bx = blockIdx.x;
    unsigned char* ws = P.ws;
    const int lo = P.ph_lo, hi = P.ph_hi;
#define IN(k) (lo <= (k) && (k) < hi)
#define SEAM(k) do { if (IN(k) && IN((k) + 1)) { if ((k) == 0) cg::this_grid().sync(); else { IDS; xcd_barrier(bar, tid); } } } while (0)
    bf16* XN = (bf16*)(ws + WS_XN); bf16* HID = (bf16*)(ws + WS_HID); float* Z = (float*)(g_buf + GB_Z);
    bf16* QA = (bf16*)(ws + WS_QA); bf16* LFb = (bf16*)(ws + WS_LF); bf16* IT = (bf16*)(ws + WS_IT); bf16* VT = (bf16*)(ws + WS_VT);
    bf16* GA = (bf16*)(g_buf + GB_GA); bf16* QB = (bf16*)(g_buf + GB_QB); bf16* KB = (bf16*)(g_buf + GB_KB); bf16* GT = (bf16*)(g_buf + GB_GT);
    bf16* Y = (bf16*)(ws + WS_Y); bf16* QMH = (bf16*)(ws + WS_QMH); bf16* PP = (bf16*)(ws + WS_P); bf16* OM = (bf16*)(ws + WS_OM);
    float* LC = (float*)(ws + WS_LC); float* BT = (float*)(ws + WS_BT); float* RSTD = (float*)(ws + WS_RSTD); float* SSQ = (float*)(ws + WS_SSQ); const float* WF = (const float*)(ws + WS_WF);
    unsigned* ctl = (unsigned*)(ws + WS_CTL);
    XcdBarrier bar; bar.bar = ctl + CW_BAR; bar.x = 0; bar.st = (volatile LAS unsigned*)(lds + MISC_OFF + 32);
    if (hi - lo > 1) { IDS; if (tid < 2) bar.st[tid] = 0u; __syncthreads(); bar = xcd_barrier_post(ctl + CW_BAR, (volatile LAS unsigned*)(lds + MISC_OFF + 32), tid); }

    if (IN(0)) { p0_prologue(KP, lds, wave); }
    SEAM(0);
    if (IN(1)) {
        { pg8::Gemm g{XN, (const bf16*)(ws + WS_W1A), M, 2 * DFF, D}; pg8::StaticOrder S; S.init(M, 2 * DFF, G, bx); pg8::EpiSwiglu E{HID, DFF};
          pg8::gemm_phase<pg8::EpiSwiglu, pg8::StaticOrder, true, true>(lds, g, S, E, wave); }
        { pg8::Gemm g{(const bf16*)(ws + WS_MEMN), (const bf16*)(ws + WS_WMKV), MROWS, 2 * D, D}; pg8::ListOrder S{MROWS / 256, G >= 144 ? 128 : 0, 16, bx}; pg8::EpiMemKV E{(bf16*)(ws + WS_KM), (bf16*)(ws + WS_VTM)};
          pg8::gemm_phase<pg8::EpiMemKV, pg8::ListOrder, false, true>(lds, g, S, E, wave); }
    }
    SEAM(1);
    if (IN(2)) { pg8::Gemm g{HID, (const bf16*)(ws + WS_W1D), M, D, DFF}; pg8::StaticOrder S; S.init(M, D, G, bx); pg8::EpiF32 E{Z, D};
        pg8::gemm_phase<pg8::EpiF32, pg8::StaticOrder, true, true>(lds, g, S, E, wave); }
    SEAM(2);
    if (IN(3)) rowpass<true, true>(P.x, Z, P.f1pg, 0.5f, P.out, P.mixg, XN, WF, P.fbias, LC, BT, lds, wave);
    SEAM(3);
    if (IN(4)) {
        { pg8::Gemm g{XN, (const bf16*)(ws + WS_WIN), M, 7168, D}; pg8::StaticOrder S; S.init(M, 7168, G, bx);
          pg8::EpiInproj E{QA, LFb, GA, QB, KB, GT, P.lbl, P.bgate, LOG2E * 0.08838834764831845f};
          pg8::gemm_phase<pg8::EpiInproj, pg8::StaticOrder, true, true>(lds, g, S, E, wave); }
        { pg8::Gemm g{(const bf16*)(ws + WS_WIN) + (size_t)7168 * D, XN, 2048, M, D}; pg8::StaticOrder S; S.init(2048, M, G, bx); pg8::EpiBf16P E{IT, M, 1.0f};
          pg8::gemm_phase<pg8::EpiBf16P, pg8::StaticOrder, true, true>(lds, g, S, E, wave); }
    }
    SEAM(4);
    if (IN(5)) {
        if (bx < 64) { hg::unit(lds, bx, QA, LFb, IT, GA, P.hgg, SSQ, wave); }
        if (G < 64) { for (int u = bx + G; u < 64; u += G) hg::unit(lds, u, QA, LFb, IT, GA, P.hgg, SSQ, wave); }
        LAS int* sh = (LAS int*)(lds + MISC_OFF); IDS;
        for (;;) {
            __syncthreads();
            if (tid == 0) sh[0] = (int)atomicAdd(ctl, 1u);
            __syncthreads();
            const int u = sh[0];
            if (u >= 512) break;
            fox::unit(lds, u, QB, KB, VT, LC, BT, wave);
        }
    }
    SEAM(5);
    if (IN(6)) {
        pg8::StaticOrder S; S.init(M, D, G, bx);
        { IDS; pg8::Unit u; for (int i = 0; S.next(i, u); ++i) { const int r = tid >> 1, sub = tid & 1; const float* sp = SSQ + (size_t)(u.pm * 256 + r) * 32 + 16 * sub; float s = 0.f;
#pragma unroll
                for (int j = 0; j < 16; ++j) s += sp[j];
                s += __shfl_xor(s, 1);
                if (sub == 0) RSTD[(size_t)u.pn * M + u.pm * 256 + r] = 1.0f / sqrtf(s * (1.0f / D) + EPS); } }
        __threadfence(); __syncthreads();
        { pg8::Gemm g{GA, (const bf16*)(ws + WS_WBA), M, D, D}; pg8::EpiBranchA E{GT, RSTD}; pg8::gemm_phase<pg8::EpiBranchA, pg8::StaticOrder, true, true>(lds, g, S, E, wave); }
        { pg8::Gemm g{QB, (const bf16*)(ws + WS_WBB), M, D, D}; pg8::EpiBranchB E{GT, Y}; pg8::gemm_phase<pg8::EpiBranchB, pg8::StaticOrder, true, true>(lds, g, S, E, wave); }
    }
    SEAM(6);
    if (IN(7)) { pg8::Gemm g{Y, (const bf16*)(ws + WS_WOUT), M, D, D}; pg8::StaticOrder S; S.init(M, D, G, bx); pg8::EpiF32 E{Z, D}; pg8::gemm_phase<pg8::EpiF32, pg8::StaticOrder, true, true>(lds, g, S, E, wave); }
    SEAM(7);
    if (IN(8)) rowpass<true, false>(P.out, Z, P.mixpg, 1.0f, P.out, P.mempg, XN, nullptr, nullptr, nullptr, nullptr, lds, wave);
    SEAM(8);
    if (IN(9)) { pg8::Gemm g{XN, (const bf16*)(ws + WS_WMQ), M, D, D}; pg8::StaticOrder S; S.init(M, D, G, bx); pg8::EpiHeadSplit E{QMH, M, LOG2E * 0.0625f};
        pg8::gemm_phase<pg8::EpiHeadSplit, pg8::StaticOrder, true, true>(lds, g, S, E, wave); }
    SEAM(9);
    if (IN(10)) {
        pg8::CrossOrder S; S.so.init(M, D, G, bx); S.Mrows = M; S.pm_per_batch = SEQ / 256;
        { pg8::Gemm g{QMH, (const bf16*)(ws + WS_KM), M, D, 256}; pg8::EpiSoftmax E{PP, M}; pg8::gemm_phase<pg8::EpiSoftmax, pg8::CrossOrder, false, true>(lds, g, S, E, wave); }
        __threadfence(); __syncthreads();
        { pg8::Gemm g{PP, (const bf16*)(ws + WS_VTM), M, D, 256}; pg8::EpiBf16P E{OM, D, 1.0f}; pg8::gemm_phase<pg8::EpiBf16P, pg8::CrossOrder, true, true>(lds, g, S, E, wave); }
    }
    SEAM(10);
    if (IN(11)) { pg8::Gemm g{OM, (const bf16*)(ws + WS_WMO), M, D, D}; pg8::StaticOrder S; S.init(M, D, G, bx); pg8::EpiF32 E{Z, D}; pg8::gemm_phase<pg8::EpiF32, pg8::StaticOrder, true, true>(lds, g, S, E, wave); }
    SEAM(11);
    if (IN(12)) rowpass<true, false>(P.out, Z, P.mempostg, 1.0f, P.out, P.f2g, XN, nullptr, nullptr, nullptr, nullptr, lds, wave);
    SEAM(12);
    if (IN(13)) { pg8::Gemm g{XN, (const bf16*)(ws + WS_W2A), M, 2 * DFF, D}; pg8::StaticOrder S; S.init(M, 2 * DFF, G, bx); pg8::EpiSwiglu E{HID, DFF};
        pg8::gemm_phase<pg8::EpiSwiglu, pg8::StaticOrder, true, true>(lds, g, S, E, wave); }
    SEAM(13);
    if (IN(14)) { pg8::Gemm g{HID, (const bf16*)(ws + WS_W2D), M, D, DFF}; pg8::StaticOrder S; S.init(M, D, G, bx); pg8::EpiF32 E{Z, D}; pg8::gemm_phase<pg8::EpiF32, pg8::StaticOrder, true, true>(lds, g, S, E, wave); }
    SEAM(14);
    if (IN(15)) rowpass<false, false>(P.out, Z, P.f2pg, 0.5f, P.out, nullptr, nullptr, nullptr, nullptr, nullptr, nullptr, lds, wave);
#undef IN
#undef SEAM
#undef P
}

extern "C" void kernel_launch(void* const* d_in, const int* in_sizes, int n_in, void* d_out, int out_size, void* d_ws, size_t ws_size, hipStream_t stream) {
    static int grid = 0;
    if (grid == 0) {
        if (n_in != 26 || in_sizes[0] != M * D || out_size != M * D || ws_size < WS_END) { fprintf(stderr, "kernel_launch: unexpected problem (n_in %d, ws %zu)\n", n_in, ws_size); grid = -1; return; }
        int dev = 0, cus = 0, per_cu = 0;
        if (hipGetDevice(&dev) != hipSuccess || hipDeviceGetAttribute(&cus, hipDeviceAttributeMultiprocessorCount, dev) != hipSuccess) { grid = -1; return; }
        if (hipFuncSetAttribute((const void*)fwd, hipFuncAttributeMaxDynamicSharedMemorySize, LDS_BYTES) != hipSuccess) { fprintf(stderr, "kernel_launch: hipFuncSetAttribute failed\n"); grid = -1; return; }
        if (hipOccupancyMaxActiveBlocksPerMultiprocessor(&per_cu, (const void*)fwd, NT, LDS_BYTES) != hipSuccess || per_cu < 1) { fprintf(stderr, "kernel_launch: occupancy query gave %d\n", per_cu); (void)hipGetLastError(); grid = -1; return; }
        grid = cus * 1;
    }
    if (grid < 0) return;
    (void)hipMemsetAsync((char*)d_ws + WS_CTL, 0, CTL_ZERO_BYTES, stream);
    Ptrs p{};
    const float** pf = (const float**)&p;
    for (int i = 0; i < 26; ++i) pf[i] = (const float*)d_in[i];
    p.out = (float*)d_out; p.ws = (unsigned char*)d_ws;
#if ONE_LAUNCH
    p.ph_lo = 0; p.ph_hi = NPHASE;
    void* args[] = {&p};
    hipError_t e = hipLaunchCooperativeKernel((const void*)fwd, dim3(grid), dim3(NT), args, LDS_BYTES, stream);
    if (e != hipSuccess) fprintf(stderr, "cooperative launch failed: %s (grid %d)\n", hipGetErrorString(e), grid);
#else
    for (int k = 0; k < NPHASE; ++k) { p.ph_lo = k; p.ph_hi = k + 1; hipLaunchKernelGGL(fwd, dim3(grid), dim3(NT), LDS_BYTES, stream, p); }
#endif
}
```

```cpp
#include <hip/hip_runtime.h>
#include <hip/hip_cooperative_groups.h>
#include <cstdio>
#include <cstdint>
#include <cmath>
namespace cg = cooperative_groups;
__device__ __forceinline__ int fresh_lane() { int l; asm volatile("v_mbcnt_lo_u32_b32 %0, -1, 0\n\tv_mbcnt_hi_u32_b32 %0, -1, %0" : "=v"(l)); return l; }
namespace pg8 {
#define PG8_LAS __attribute__((address_space(3)))
typedef unsigned short bf16_t;
typedef short bf16x8 __attribute__((ext_vector_type(8)));
typedef float f32x4 __attribute__((ext_vector_type(4)));
typedef unsigned u32x4 __attribute__((ext_vector_type(4)));
constexpr int BM = 256, BK = 64, HALF = 128, HTB = HALF * BK * 2  , STAGE_BYTES = 8 * HTB, NXCD = 8, WGM = 8;

__host__ __device__ __forceinline__ int lds_byte(int r, int c) { const int st = (r >> 4) * 2 + (c >> 5), rr = r & 15, cc = c & 31, ob = rr * 64 + cc * 2; return st * 1024 + (ob ^ (((ob >> 9) & 1) << 5)); }
__host__ __device__ __forceinline__ void stage_rc(int b, int& R, int& C) { const int st = b / 1024, sb = b % 1024, swz = sb ^ (((sb >> 9) & 1) << 5); R = (st >> 1) * 16 + swz / 64; C = (st & 1) * 32 + (swz % 64) / 2; }
__host__ __device__ __forceinline__ int perm32(int rho) { const int n = rho >> 4, i = rho & 15; return 8 * (i >> 2) + 4 * n + (i & 3); }

struct Unit { int pm, pn; };
struct Gemm { const bf16_t* A; const bf16_t* Bt; int M, N, K; };

struct StaticOrder {
    int nM, nN, nwg, G, c;
    __host__ __device__ void init(int M, int N, int G_, int c_) { nM = M / BM; nN = N / BM; nwg = nM * nN; G = G_; c = c_; }
    __host__ __device__ bool next(int i, Unit& u) const {
        const long L = (long)i * G + c; if (L >= nwg) return false;
        int wgid = (int)L; { const int q = nwg / NXCD, r = nwg % NXCD, xcd = wgid % NXCD, off = wgid / NXCD; wgid = (xcd < r ? xcd * (q + 1) : r * (q + 1) + (xcd - r) * q) + off; }
        const int nig = WGM * nN, gid = wgid / nig, fm = gid * WGM, gsz = (nM - fm) < WGM ? (nM - fm) : WGM;
        u.pm = fm + ((wgid % nig) % gsz); u.pn = (wgid % nig) / gsz; return true;
    }
    __device__ __forceinline__ const char* pa(const Gemm& g, const Unit& u) const { return (const char*)g.A + (size_t)u.pm * ((size_t)BM * g.K * 2); }
    __device__ __forceinline__ const char* pb(const Gemm& g, const Unit& u) const { return (const char*)g.Bt + (size_t)u.pn * ((size_t)BM * g.K * 2); }
    __device__ __forceinline__ void a_ready(const Unit&) const {}
    __device__ __forceinline__ void done(const Unit&) const {}
};


struct ListOrder {
    int nM, c0, n, c;
    __device__ bool next(int i, Unit& u) const { const int idx = c - c0; if (i != 0 || idx < 0 || idx >= n) return false; u.pm = idx % nM; u.pn = idx / nM; return true; }
    __device__ __forceinline__ const char* pa(const Gemm& g, const Unit& u) const { return (const char*)g.A + (size_t)u.pm * ((size_t)BM * g.K * 2); }
    __device__ __forceinline__ const char* pb(const Gemm& g, const Unit& u) const { return (const char*)g.Bt + (size_t)u.pn * ((size_t)BM * g.K * 2); }
    __device__ __forceinline__ void a_ready(const Unit&) const {}
    __device__ __forceinline__ void done(const Unit&) const {}
};
struct CrossOrder {
    StaticOrder so; int Mrows, pm_per_batch;
    __device__ bool next(int i, Unit& u) const { return so.next(i, u); }
    __device__ __forceinline__ const char* pa(const Gemm& g, const Unit& u) const { return (const char*)g.A + ((size_t)u.pn * Mrows + (size_t)u.pm * BM) * ((size_t)g.K * 2); }
    __device__ __forceinline__ const char* pb(const Gemm& g, const Unit& u) const { return (const char*)g.Bt + ((size_t)(u.pn * 2 + u.pm / pm_per_batch) * BM) * ((size_t)g.K * 2); }
    __device__ __forceinline__ void a_ready(const Unit&) const {}
    __device__ __forceinline__ void done(const Unit&) const {}
};

__device__ __forceinline__ unsigned f2bf_(float f) { unsigned u = __builtin_bit_cast(unsigned, f); return (u + 0x7fffu + ((u >> 16) & 1u)) >> 16; }
__device__ __forceinline__ unsigned pk2_(float lo, float hi) { return f2bf_(lo) | (f2bf_(hi) << 16); }
__device__ __forceinline__ float bf2f_(unsigned v) { return __builtin_bit_cast(float, v << 16); }
typedef unsigned u32x2 __attribute__((ext_vector_type(2)));
__device__ __forceinline__ void st_bf4(bf16_t* p, f32x4 v) { u32x2 w; w.x = pk2_(v[0], v[1]); w.y = pk2_(v[2], v[3]); *(u32x2*)p = w; }
__device__ __forceinline__ f32x4 ld_bf4(const bf16_t* p) { const u32x2 w = *(const u32x2*)p; return (f32x4){bf2f_(w.x & 0xffffu), bf2f_(w.x >> 16), bf2f_(w.y & 0xffffu), bf2f_(w.y >> 16)}; }
__device__ __forceinline__ float sigm(float x) { return 1.0f / (1.0f + __expf(-x)); }
__device__ __forceinline__ float silu_(float x) { return x / (1.0f + __expf(-x)); }

#define PG8_FOREACH_BEGIN \
    _Pragma("unroll") for (int ai = 0; ai < 2; ++ai) _Pragma("unroll") for (int m = 0; m < 4; ++m) { const int row = u.pm * BM + ai * HALF + wr * 64 + m * 16 + fr; \
    _Pragma("unroll") for (int bj = 0; bj < 2; ++bj) _Pragma("unroll") for (int n = 0; n < 2; ++n) { const int col = u.pn * BM + bj * HALF + wc * 32 + n * 16 + 4 * fq; const f32x4 v = acc[ai][bj][m][n];
#define PG8_FOREACH_END } }

struct EpiF32 {
    static constexpr bool PERM = false, AFTER_DRAIN = false; float* O; int ldc;
    __device__ __forceinline__ void operator()(const f32x4 (&acc)[2][2][4][2], const Unit& u, int wr, int wc, int fr, int fq) const {
        PG8_FOREACH_BEGIN *(f32x4*)(O + (size_t)row * ldc + col) = v; PG8_FOREACH_END
    }
};
struct EpiBf16P {
    static constexpr bool PERM = false, AFTER_DRAIN = false; bf16_t* O; int ldc; float sc;
    __device__ __forceinline__ void operator()(const f32x4 (&acc)[2][2][4][2], const Unit& u, int wr, int wc, int fr, int fq) const {
        PG8_FOREACH_BEGIN st_bf4(O + (size_t)row * ldc + col, v * sc); PG8_FOREACH_END
    }
};
struct EpiSwiglu {
    static constexpr bool PERM = false, AFTER_DRAIN = false; bf16_t* O; int ldc;
    __device__ __forceinline__ void operator()(const f32x4 (&acc)[2][2][4][2], const Unit& u, int wr, int wc, int fr, int fq) const {
#pragma unroll
        for (int ai = 0; ai < 2; ++ai)
#pragma unroll
            for (int m = 0; m < 4; ++m) { const int row = u.pm * BM + ai * HALF + wr * 64 + m * 16 + fr;
#pragma unroll
                for (int n = 0; n < 2; ++n) { const int col = u.pn * HALF + wc * 32 + n * 16 + 4 * fq; const f32x4 g = acc[ai][0][m][n], up = acc[ai][1][m][n];
                    f32x4 h; h[0] = silu_(g[0]) * up[0]; h[1] = silu_(g[1]) * up[1]; h[2] = silu_(g[2]) * up[2]; h[3] = silu_(g[3]) * up[3];
                    st_bf4(O + (size_t)row * ldc + col, h); } }
    }
};
struct EpiInproj {
    static constexpr bool PERM = false, AFTER_DRAIN = false;
    bf16_t *QA, *LF, *GA, *QB, *KB, *GT; const float* lbl; const float* bgate; float qscale;
    __device__ __forceinline__ void operator()(const f32x4 (&acc)[2][2][4][2], const Unit& u, int wr, int wc, int fr, int fq) const {
        const int cls = u.pn >> 2;
        if (cls == 0 || cls == 2) { bf16_t* O = cls == 0 ? QA : GA; const int c0 = cls * 1024;
            PG8_FOREACH_BEGIN f32x4 o; o[0] = silu_(v[0]); o[1] = silu_(v[1]); o[2] = silu_(v[2]); o[3] = silu_(v[3]); st_bf4(O + (size_t)row * 1024 + (col - c0), o); PG8_FOREACH_END
        } else if (cls == 1) {
            PG8_FOREACH_BEGIN const int c = col - 1024; const f32x4 l0 = *(const f32x4*)(lbl + c), l1 = *(const f32x4*)(lbl + 1024 + c); f32x4 o;
#pragma unroll
                for (int e = 0; e < 4; ++e) { const float lb = 1.0f / (1.0f + __expf(l1[e] - l0[e])); const float f = lb + (1.0f - lb) * sigm(v[e]); o[e] = __logf(f); }
                st_bf4(LF + (size_t)row * 1024 + c, o); PG8_FOREACH_END
        } else if (cls == 3) {
            PG8_FOREACH_BEGIN st_bf4(QB + (size_t)row * 1024 + (col - 3072), v * qscale); PG8_FOREACH_END
        } else if (cls == 4) {
            PG8_FOREACH_BEGIN st_bf4(KB + (size_t)row * 1024 + (col - 4096), v); PG8_FOREACH_END
        } else {
            PG8_FOREACH_BEGIN const int c = col - 5120; const f32x4 bg = *(const f32x4*)(bgate + c); f32x4 o; o[0] = sigm(v[0] + bg[0]); o[1] = sigm(v[1] + bg[1]); o[2] = sigm(v[2] + bg[2]); o[3] = sigm(v[3] + bg[3]);
                st_bf4(GT + (size_t)row * 2048 + c, o); PG8_FOREACH_END
        }
    }
};
struct EpiBranchA {
    static constexpr bool PERM = false, AFTER_DRAIN = false; bf16_t* GT; const float* rstd;
    __device__ __forceinline__ void operator()(const f32x4 (&acc)[2][2][4][2], const Unit& u, int wr, int wc, int fr, int fq) const {
        const float* rs = rstd + (size_t)u.pn * 16384;
        PG8_FOREACH_BEGIN bf16_t* p = GT + (size_t)row * 2048 + col; const f32x4 g0 = ld_bf4(p); const float r = rs[row]; st_bf4(p, g0 * v * r); PG8_FOREACH_END
    }
};
struct EpiBranchB {
    static constexpr bool PERM = false, AFTER_DRAIN = false; const bf16_t* GT; bf16_t* Y;
    __device__ __forceinline__ void operator()(const f32x4 (&acc)[2][2][4][2], const Unit& u, int wr, int wc, int fr, int fq) const {
        PG8_FOREACH_BEGIN const bf16_t* p = GT + (size_t)row * 2048 + col; const f32x4 t = ld_bf4(p), g1 = ld_bf4(p + 1024); st_bf4(Y + (size_t)row * 1024 + col, t + g1 * v); PG8_FOREACH_END
    }
};
struct EpiHeadSplit {
    static constexpr bool PERM = false, AFTER_DRAIN = false; bf16_t* O; int Mrows; float sc;
    __device__ __forceinline__ void operator()(const f32x4 (&acc)[2][2][4][2], const Unit& u, int wr, int wc, int fr, int fq) const {
        PG8_FOREACH_BEGIN st_bf4(O + ((size_t)u.pn * Mrows + row) * 256 + (col - u.pn * BM), v * sc); PG8_FOREACH_END
    }
};
struct EpiMemKV {
    static constexpr bool PERM = false, AFTER_DRAIN = false; bf16_t *KM, *VTM;
    __device__ __forceinline__ void operator()(const f32x4 (&acc)[2][2][4][2], const Unit& u, int wr, int wc, int fr, int fq) const {
        if (u.pn < 4) { PG8_FOREACH_BEGIN st_bf4(KM + ((size_t)u.pn * 512 + row) * 256 + (col - u.pn * BM), v); PG8_FOREACH_END }
        else { const int h = u.pn - 4;
            PG8_FOREACH_BEGIN const int d = col - u.pn * BM, b = row >> 8, key = row & 255; bf16_t* p = VTM + ((size_t)(h * 2 + b) * 256 + d) * 256 + key;
                p[0] = (bf16_t)f2bf_(v[0]); p[256] = (bf16_t)f2bf_(v[1]); p[512] = (bf16_t)f2bf_(v[2]); p[768] = (bf16_t)f2bf_(v[3]); PG8_FOREACH_END }
    }
};
struct EpiSoftmax {
    static constexpr bool PERM = false, AFTER_DRAIN = true; bf16_t* P; int Mrows;
    __device__ __forceinline__ void fused(f32x4 (&acc)[2][2][4][2], const Unit& u, int wr, int wc, int fr, int fq, PG8_LAS unsigned char* lds, int wid, int lane) const {
        typedef float f32x2v __attribute__((ext_vector_type(2)));
        PG8_LAS f32x2v* X = (PG8_LAS f32x2v*)lds;
        float mx[2][4];
#pragma unroll
        for (int ai = 0; ai < 2; ++ai)
#pragma unroll
            for (int m = 0; m < 4; ++m) { float a = -INFINITY;
#pragma unroll
                for (int bj = 0; bj < 2; ++bj)
#pragma unroll
                    for (int n = 0; n < 2; ++n) { const f32x4 v = acc[ai][bj][m][n]; a = fmaxf(a, fmaxf(fmaxf(v[0], v[1]), fmaxf(v[2], v[3]))); }
                a = fmaxf(a, __shfl_xor(a, 16)); a = fmaxf(a, __shfl_xor(a, 32)); float s = 0.f;
#pragma unroll
                for (int bj = 0; bj < 2; ++bj)
#pragma unroll
                    for (int n = 0; n < 2; ++n) { const f32x4 v = acc[ai][bj][m][n]; s += (__builtin_amdgcn_exp2f(v[0] - a) + __builtin_amdgcn_exp2f(v[1] - a)) + (__builtin_amdgcn_exp2f(v[2] - a) + __builtin_amdgcn_exp2f(v[3] - a)); }
                s += __shfl_xor(s, 16); s += __shfl_xor(s, 32); mx[ai][m] = a;
                if (fq == 0) X[(ai * HALF + wr * 64 + m * 16 + fr) * 4 + wc] = (f32x2v){a, s}; }
        asm volatile("s_waitcnt lgkmcnt(0)" ::: "memory"); __builtin_amdgcn_s_barrier(); asm volatile("" ::: "memory");
#pragma unroll
        for (int ai = 0; ai < 2; ++ai)
#pragma unroll
            for (int m = 0; m < 4; ++m) { const int rl = ai * HALF + wr * 64 + m * 16 + fr; const f32x2v a = X[rl * 4 + 0], b = X[rl * 4 + 1], c = X[rl * 4 + 2], d = X[rl * 4 + 3];
                const float gm = fmaxf(fmaxf(a.x, b.x), fmaxf(c.x, d.x));
                const float gs = (a.y * __builtin_amdgcn_exp2f(a.x - gm) + b.y * __builtin_amdgcn_exp2f(b.x - gm)) + (c.y * __builtin_amdgcn_exp2f(c.x - gm) + d.y * __builtin_amdgcn_exp2f(d.x - gm));
                const float inv = 1.0f / gs; const int row = u.pm * BM + rl;
#pragma unroll
                for (int bj = 0; bj < 2; ++bj)
#pragma unroll
                    for (int n = 0; n < 2; ++n) { const int cl = bj * HALF + wc * 32 + n * 16 + 4 * fq; const f32x4 v = acc[ai][bj][m][n]; f32x4 p;
                        p[0] = __builtin_amdgcn_exp2f(v[0] - gm) * inv; p[1] = __builtin_amdgcn_exp2f(v[1] - gm) * inv; p[2] = __builtin_amdgcn_exp2f(v[2] - gm) * inv; p[3] = __builtin_amdgcn_exp2f(v[3] - gm) * inv;
                        st_bf4(P + ((size_t)u.pn * Mrows + row) * 256 + cl, p); } }
        (void)mx; (void)wid; (void)lane;
    }
};
template <class Epi, class Sched, bool ALIGN_EPI = false, bool SP2 = false>
__device__ __forceinline__ void gemm_phase(PG8_LAS unsigned char* lds, const Gemm g, const Sched& S, const Epi& E, const int wave_s) {
    const int lane = fresh_lane(), wid = wave_s, tid = wid * 64 + lane, wr = wid >> 2, wc = wid & 3, fr = lane & 15, fq = lane >> 4;
    const int K = g.K, nt = K / BK;
    unsigned voffA[2], voffB[2];
#pragma unroll
    for (int i = 0; i < 2; ++i) { int R, C; stage_rc(tid * 16 + i * 8192, R, C); const int Rb = Epi::PERM ? ((R & ~31) + perm32(R & 31)) : R;
        voffA[i] = (unsigned)(R * K + C) * 2u; voffB[i] = (unsigned)(Rb * K + C) * 2u; }
    const size_t kstep = (size_t)(BK * 2);
    const size_t hstep = (size_t)HALF * K * 2;
    const size_t tstep = 2 * hstep;
    const unsigned ldsw = (unsigned)wid * 1024u;
    const int aoff = lds_byte(wr * 64 + fr, fq * 8), boff = lds_byte(wc * 32 + fr, fq * 8);
#define PG8_SA(b, h) (((b) * 2 + (h)) * HTB)
#define PG8_SB(b, h) ((4 + (b) * 2 + (h)) * HTB)
#define PG8_STAGE(bufoff, gbase, voff) do { _Pragma("unroll") for (int _i = 0; _i < 2; ++_i) \
        __builtin_amdgcn_global_load_lds((const unsigned*)((const char*)(gbase) + (voff)[_i]), (PG8_LAS unsigned*)(lds + (bufoff) + ldsw + _i * 8192), 16, 0, 0); } while (0)
#define PG8_LDA(dst, b, h) do { _Pragma("unroll") for (int m = 0; m < 4; ++m) _Pragma("unroll") for (int k = 0; k < 2; ++k) dst[m][k] = *(const PG8_LAS bf16x8*)(lds + PG8_SA(b, h) + aoff + m * 2048 + k * 1024); } while (0)
#define PG8_LDB(dst, b, h) do { _Pragma("unroll") for (int n = 0; n < 2; ++n) _Pragma("unroll") for (int k = 0; k < 2; ++k) dst[n][k] = *(const PG8_LAS bf16x8*)(lds + PG8_SB(b, h) + boff + n * 2048 + k * 1024); } while (0)
#define PG8_MMA(ai, bj, At, Bt) do { __builtin_amdgcn_s_setprio(1); _Pragma("unroll") for (int m = 0; m < 4; ++m) _Pragma("unroll") for (int n = 0; n < 2; ++n) _Pragma("unroll") for (int k = 0; k < 2; ++k) \
        acc[ai][bj][m][n] = __builtin_amdgcn_mfma_f32_16x16x32_bf16(Bt[n][k], At[m][k], acc[ai][bj][m][n], 0, 0, 0); __builtin_amdgcn_s_setprio(0); } while (0)
#define PG8_WAIT_V(n) asm volatile("s_waitcnt vmcnt(" #n ")" ::: "memory")
#define PG8_WAIT_L(n) asm volatile("s_waitcnt lgkmcnt(" #n ")" ::: "memory")
#define PG8_BAR __builtin_amdgcn_s_barrier()
#define PG8_SCHED __builtin_amdgcn_sched_barrier(0)
    Unit cur, nxt; int ui = 0;
    if (!S.next(0, cur)) return;
    f32x4 acc[2][2][4][2];
#pragma unroll
    for (int a = 0; a < 2; ++a)
#pragma unroll
        for (int b = 0; b < 2; ++b)
#pragma unroll
            for (int m = 0; m < 4; ++m)
#pragma unroll
                for (int n = 0; n < 2; ++n) acc[a][b][m][n] = (f32x4){0.f, 0.f, 0.f, 0.f};
    bf16x8 At[4][2], B0[2][2], B1[2][2];
    const char* cA = S.pa(g, cur); const char* cB = S.pb(g, cur);
    S.a_ready(cur);
    if constexpr (SP2) {
        PG8_STAGE(PG8_SB(0, 0), cB, voffB); PG8_STAGE(PG8_SB(0, 1), cB + hstep, voffB); PG8_STAGE(PG8_SA(0, 0), cA, voffA); PG8_STAGE(PG8_SA(0, 1), cA + hstep, voffA);
        if (wr == 1) PG8_BAR;
        PG8_WAIT_V(2); PG8_BAR;
        PG8_STAGE(PG8_SB(1, 0), cB + kstep, voffB); PG8_STAGE(PG8_SA(1, 0), cA + kstep, voffA); PG8_STAGE(PG8_SB(1, 1), cB + hstep + kstep, voffB);
        PG8_WAIT_V(6); PG8_BAR;
    } else {
        PG8_STAGE(PG8_SB(0, 0), cB, voffB); PG8_STAGE(PG8_SA(0, 0), cA, voffA); PG8_STAGE(PG8_SB(0, 1), cB + hstep, voffB); PG8_STAGE(PG8_SA(0, 1), cA + hstep, voffA);
        if (wr == 1) PG8_BAR;
        PG8_WAIT_V(4); PG8_BAR;
        PG8_STAGE(PG8_SB(1, 0), cB + kstep, voffB); PG8_STAGE(PG8_SA(1, 0), cA + kstep, voffA); PG8_STAGE(PG8_SB(1, 1), cB + hstep + kstep, voffB);
        PG8_WAIT_V(6); PG8_BAR;
    }
    for (;;) {
        const bool has_next = S.next(ui + 1, nxt);
        const char* nA = has_next ? S.pa(g, nxt) : cA; const char* nB = has_next ? S.pb(g, nxt) : cB;
        for (int t = 0; t < nt; t += 2) {
            const bool last = (t == nt - 2);
            const char* a1 = cA + (size_t)(t + 1) * kstep;
            const char* a2 = last ? nA : cA + (size_t)(t + 2) * kstep; const char* b2 = last ? nB : cB + (size_t)(t + 2) * kstep;
            const char* a3 = a2 + kstep; const char* b3 = b2 + kstep;
            if (last && has_next) S.a_ready(nxt);
            if constexpr (SP2) {
            PG8_LDB(B0, 0, 0); PG8_LDB(B1, 0, 1); PG8_SCHED; PG8_LDA(At, 0, 0); PG8_STAGE(PG8_SA(1, 1), a1 + hstep, voffA);
            PG8_WAIT_V(8); PG8_WAIT_L(0); PG8_BAR; PG8_MMA(0, 0, At, B0); PG8_MMA(0, 1, At, B1); PG8_BAR; PG8_SCHED;
            PG8_LDA(At, 0, 1); PG8_STAGE(PG8_SB(0, 0), b2, voffB); PG8_STAGE(PG8_SB(0, 1), b2 + hstep, voffB); PG8_STAGE(PG8_SA(0, 0), a2, voffA);
            PG8_WAIT_V(8); PG8_WAIT_L(0); PG8_BAR; PG8_MMA(1, 0, At, B0); PG8_MMA(1, 1, At, B1); PG8_BAR; PG8_SCHED;
            PG8_LDB(B0, 1, 0); PG8_LDB(B1, 1, 1); PG8_SCHED; PG8_LDA(At, 1, 0); PG8_STAGE(PG8_SA(0, 1), a2 + hstep, voffA);
            PG8_WAIT_V(8); PG8_WAIT_L(0); PG8_BAR; PG8_MMA(0, 0, At, B0); PG8_MMA(0, 1, At, B1); PG8_BAR; PG8_SCHED;
            PG8_LDA(At, 1, 1); PG8_STAGE(PG8_SB(1, 0), b3, voffB); PG8_STAGE(PG8_SB(1, 1), b3 + hstep, voffB); PG8_STAGE(PG8_SA(1, 0), a3, voffA);
            PG8_WAIT_V(8); PG8_WAIT_L(0); PG8_BAR; PG8_MMA(1, 0, At, B0); PG8_MMA(1, 1, At, B1); PG8_BAR; PG8_SCHED;
            } else {
            PG8_LDB(B0, 0, 0); PG8_SCHED; PG8_LDA(At, 0, 0); PG8_STAGE(PG8_SA(1, 1), a1 + hstep, voffA);
            PG8_WAIT_L(8); PG8_BAR; PG8_WAIT_L(0); PG8_MMA(0, 0, At, B0); PG8_BAR; PG8_SCHED;
            PG8_LDB(B1, 0, 1); PG8_STAGE(PG8_SB(0, 0), b2, voffB);
            PG8_BAR; PG8_WAIT_L(0); PG8_MMA(0, 1, At, B1); PG8_BAR;
            PG8_LDA(At, 0, 1); PG8_STAGE(PG8_SA(0, 0), a2, voffA);
            PG8_BAR; PG8_WAIT_L(0); PG8_MMA(1, 0, At, B0); PG8_BAR; PG8_SCHED;
            PG8_STAGE(PG8_SB(0, 1), b2 + hstep, voffB);
            PG8_WAIT_V(6); PG8_BAR; PG8_MMA(1, 1, At, B1); PG8_BAR;
            PG8_LDB(B0, 1, 0); PG8_SCHED; PG8_LDA(At, 1, 0); PG8_STAGE(PG8_SA(0, 1), a2 + hstep, voffA);
            PG8_WAIT_L(8); PG8_BAR; PG8_WAIT_L(0); PG8_MMA(0, 0, At, B0); PG8_BAR; PG8_SCHED;
            PG8_LDB(B1, 1, 1); PG8_STAGE(PG8_SB(1, 0), b3, voffB);
            PG8_BAR; PG8_WAIT_L(0); PG8_MMA(0, 1, At, B1); PG8_BAR;
            PG8_LDA(At, 1, 1); PG8_STAGE(PG8_SA(1, 0), a3, voffA);
            PG8_BAR; PG8_WAIT_L(0); PG8_MMA(1, 0, At, B0); PG8_BAR; PG8_SCHED;
            PG8_STAGE(PG8_SB(1, 1), b3 + hstep, voffB);
            PG8_WAIT_V(6); PG8_BAR; PG8_MMA(1, 1, At, B1); PG8_BAR;
            }
        }
        if constexpr (ALIGN_EPI) { if (wr == 0) PG8_BAR; }
        if constexpr (!Epi::AFTER_DRAIN) { E(acc, cur, wr, wc, fr, fq); S.done(cur); }
        if (!has_next) break;
#pragma unroll
        for (int a = 0; a < 2; ++a)
#pragma unroll
            for (int b = 0; b < 2; ++b)
#pragma unroll
                for (int m = 0; m < 4; ++m)
#pragma unroll
                    for (int n = 0; n < 2; ++n) acc[a][b][m][n] = (f32x4){0.f, 0.f, 0.f, 0.f};
        cur = nxt; cA = nA; cB = nB; ++ui;
        if constexpr (ALIGN_EPI) { if (wr == 1) PG8_BAR; }
    }
    PG8_WAIT_V(0);
    if constexpr (!ALIGN_EPI) { if (wr == 0) PG8_BAR; }
    PG8_BAR;
    if constexpr (Epi::AFTER_DRAIN) { E.fused(acc, cur, wr, wc, fr, fq, lds, wid, lane); S.done(cur); }
#undef PG8_SA
#undef PG8_SB
#undef PG8_STAGE
#undef PG8_LDA
#undef PG8_LDB
#undef PG8_MMA
#undef PG8_WAIT_V
#undef PG8_WAIT_L
#undef PG8_BAR
#undef PG8_SCHED
}
}

constexpr int NW = 8, NT = NW * 64;
constexpr int BATCH = 2, SEQ = 8192, D = 1024, M = BATCH * SEQ, DFF = 2816, NH = 8, DH = 128, MEMLEN = 256, MROWS = BATCH * MEMLEN;
constexpr int IN_COLS = 9224;
constexpr float EPS = 1e-6f, LOG2E = 1.4426950408889634f;
constexpr int LDS_BYTES = 147456, RING_BYTES = 131072, MISC_OFF = RING_BYTES;
constexpr int NPHASE = 16;
#ifndef ONE_LAUNCH
#define ONE_LAUNCH 1
#endif

constexpr size_t MiB = 1u << 20;
constexpr size_t WS_CTL = 0, CTL_ZERO_BYTES = 65536;
constexpr int CW_BAR = 4096;
constexpr size_t WS_WF = 1 * MiB;
constexpr size_t WS_LC = 1 * MiB + 64 * 1024;
constexpr size_t WS_BT = 1 * MiB + 640 * 1024;
constexpr size_t WS_RSTD = 1 * MiB + 704 * 1024;
constexpr size_t WS_SSQ = 2 * MiB;
constexpr size_t WS_MEMN = 4 * MiB;
constexpr size_t WS_KM = 5 * MiB;
constexpr size_t WS_VTM = 6 * MiB;
constexpr size_t WS_W1A = 8 * MiB, WS_W1D = WS_W1A + 11 * MiB, WS_WIN = WS_W1D + 11 * MiB / 2, WS_WBA = WS_WIN + 18 * MiB, WS_WBB = WS_WBA + 2 * MiB, WS_WOUT = WS_WBB + 2 * MiB,
                 WS_WMQ = WS_WOUT + 2 * MiB, WS_WMO = WS_WMQ + 2 * MiB, WS_WMKV = WS_WMO + 2 * MiB, WS_W2A = WS_WMKV + 4 * MiB, WS_W2D = WS_W2A + 11 * MiB, WS_WEND = WS_W2D + 11 * MiB / 2;
static_assert(WS_WEND == 73 * MiB, "weights map");
constexpr size_t WS_XN = 74 * MiB;
constexpr size_t WS_R = 106 * MiB;
constexpr size_t WS_HID = WS_R;
constexpr size_t WS_QA = WS_R, WS_LF = WS_R + 32 * MiB, WS_IT = WS_R + 64 * MiB, WS_VT = WS_R + 96 * MiB;
constexpr size_t WS_Y = WS_R, WS_QMH = WS_R + 32 * MiB, WS_P = WS_R + 64 * MiB, WS_OM = WS_R + 96 * MiB;
constexpr size_t WS_END = 256 * MiB;
constexpr size_t GB_Z = 0, GB_GA = 0, GB_QB = 32 * MiB, GB_KB = 64 * MiB, GB_GT = 96 * MiB, GB_BYTES = 160 * MiB;
__device__ __attribute__((aligned(256))) unsigned char g_buf[GB_BYTES];

#define LAS __attribute__((address_space(3)))
typedef unsigned short bf16;
typedef unsigned v4u __attribute__((ext_vector_type(4)));
typedef unsigned v2u __attribute__((ext_vector_type(2)));
typedef float f32x4 __attribute__((ext_vector_type(4)));
typedef float f32x16 __attribute__((ext_vector_type(16)));
typedef short bf16x8 __attribute__((ext_vector_type(8)));
__device__ __forceinline__ unsigned f2bf(float f) { unsigned u = __builtin_bit_cast(unsigned, f); return (u + 0x7fffu + ((u >> 16) & 1u)) >> 16; }
__device__ __forceinline__ unsigned pk2(float lo, float hi) { return f2bf(lo) | (f2bf(hi) << 16); }
__device__ __forceinline__ float bf2f(unsigned v) { return __builtin_bit_cast(float, v << 16); }
__device__ __forceinline__ float wave_sum(float v) {
#pragma unroll
    for (int o = 1; o < 64; o <<= 1) v += __shfl_xor(v, o);
    return v;
}
#define MFMA32(a, b, c) __builtin_amdgcn_mfma_f32_32x32x16_bf16((a), (b), (c), 0, 0, 0)
__device__ __forceinline__ int crow(int reg, int h) { return (reg & 3) + 8 * (reg >> 2) + 4 * h; }
__device__ __forceinline__ int prow(int m) { return (m & 0x13) | ((m & 4) << 1) | ((m & 8) >> 1); }
__device__ __forceinline__ bf16x8 pack8(const f32x16& x, int s) {
    v4u p; p.x = pk2(x[8 * s + 0], x[8 * s + 1]); p.y = pk2(x[8 * s + 2], x[8 * s + 3]); p.z = pk2(x[8 * s + 4], x[8 * s + 5]); p.w = pk2(x[8 * s + 6], x[8 * s + 7]);
    return __builtin_bit_cast(bf16x8, p);
}

struct Ptrs {
    const float *x, *mem, *f1g, *f1wi, *f1wd, *f1pg, *mixg, *win, *lbl, *hgg, *fbias, *wba, *wbb, *bgate, *wout, *mixpg, *mempg, *memkvg, *wmq, *wmkv, *wmo, *mempostg, *f2g, *f2wi, *f2wd, *f2pg;
    float* out; unsigned char* ws; int ph_lo, ph_hi;
};

__device__ __forceinline__ void transpose_item(const float* W, int K, int N, bf16* WT, int kb, int n_src, int n_dst, LAS float* scr, int lane) {
    const int k0 = 64 * kb;
#pragma unroll 8
    for (int i = 0; i < 32; ++i) { const int kk = 2 * i + (lane >> 5); scr[kk * 33 + (lane & 31)] = W[(size_t)(k0 + kk) * N + n_src + (lane & 31)]; }
    asm volatile("s_waitcnt lgkmcnt(0)" ::: "memory");
    const int c = lane & 7;
#pragma unroll
    for (int j = 0; j < 4; ++j) { const int n = (lane >> 3) + 8 * j; const LAS float* s = scr + (8 * c) * 33 + n;
        v4u o; o.x = pk2(s[0 * 33], s[1 * 33]); o.y = pk2(s[2 * 33], s[3 * 33]); o.z = pk2(s[4 * 33], s[5 * 33]); o.w = pk2(s[6 * 33], s[7 * 33]);
        *(v4u*)(WT + (size_t)(n_dst + n) * K + k0 + 8 * c) = o; }
    asm volatile("s_waitcnt lgkmcnt(0)" ::: "memory");
}
__device__ __forceinline__ void rms_row_to_bf16(const float* xrow, const float* g, bf16* orow, int lane) {
    const f32x4* xr = (const f32x4*)xrow + lane; const f32x4* gr = (const f32x4*)g + lane;
    f32x4 v[4]; float s = 0.f;
#pragma unroll
    for (int j = 0; j < 4; ++j) { v[j] = xr[64 * j]; s += (v[j][0] * v[j][0] + v[j][1] * v[j][1]) + (v[j][2] * v[j][2] + v[j][3] * v[j][3]); }
    const float rs = 1.0f / sqrtf(wave_sum(s) * (1.0f / D) + EPS);
    v2u* o8 = (v2u*)orow + lane;
#pragma unroll
    for (int j = 0; j < 4; ++j) { const f32x4 gg = gr[64 * j]; v2u w; w.x = pk2(v[j][0] * rs * gg[0], v[j][1] * rs * gg[1]); w.y = pk2(v[j][2] * rs * gg[2], v[j][3] * rs * gg[3]); o8[64 * j] = w; }
}

struct TItem { const float* W; int K, N; bf16* WT; int nblk; int kind; };
typedef const __attribute__((address_space(4))) Ptrs* KPtr0;
__device__ __forceinline__ void p0_prologue(KPtr0 KP, LAS unsigned char* lds, int wave) {
#define P (*KP)
    const int lane = fresh_lane();
    unsigned char* ws = P.ws;
    LAS float* scr = (LAS float*)(lds + wave * 16384);
    const int gw = blockIdx.x * NW + wave, NGW = gridDim.x * NW;
    constexpr int I_1A = 16 * 176, I_1D = 44 * 32, I_IN = 16 * 288, I_SQ = 16 * 32, I_KV = 16 * 64;
    constexpr int NITEMS = 2 * I_1A + 2 * I_1D + I_IN + 5 * I_SQ + I_KV;
    for (int it = gw; it < NITEMS; it += NGW) {
        int r = it; const float* W; int K, N, kind; bf16* WT;
        if (r < I_1A) { W = P.f1wi; K = D; N = 2 * DFF; WT = (bf16*)(ws + WS_W1A); kind = 1; }
        else if ((r -= I_1A) < I_1A) { W = P.f2wi; K = D; N = 2 * DFF; WT = (bf16*)(ws + WS_W2A); kind = 1; }
        else if ((r -= I_1A) < I_1D) { W = P.f1wd; K = DFF; N = D; WT = (bf16*)(ws + WS_W1D); kind = 0; }
        else if ((r -= I_1D) < I_1D) { W = P.f2wd; K = DFF; N = D; WT = (bf16*)(ws + WS_W2D); kind = 0; }
        else if ((r -= I_1D) < I_IN) { W = P.win; K = D; N = IN_COLS; WT = (bf16*)(ws + WS_WIN); kind = 2; }
        else if ((r -= I_IN) < I_SQ) { W = P.wba; K = D; N = D; WT = (bf16*)(ws + WS_WBA); kind = 0; }
        else if ((r -= I_SQ) < I_SQ) { W = P.wbb; K = D; N = D; WT = (bf16*)(ws + WS_WBB); kind = 0; }
        else if ((r -= I_SQ) < I_SQ) { W = P.wout; K = D; N = D; WT = (bf16*)(ws + WS_WOUT); kind = 0; }
        else if ((r -= I_SQ) < I_SQ) { W = P.wmq; K = D; N = D; WT = (bf16*)(ws + WS_WMQ); kind = 0; }
        else if ((r -= I_SQ) < I_SQ) { W = P.wmo; K = D; N = D; WT = (bf16*)(ws + WS_WMO); kind = 0; }
        else { r -= I_SQ; W = P.wmkv; K = D; N = 2 * D; WT = (bf16*)(ws + WS_WMKV); kind = 0; }
        int ndb = (kind == 2) ? 288 : N / 32;
        const int kb = r / ndb, nb = r % ndb; const int n_dst = 32 * nb; int n_src = n_dst;
        if (kind == 1) { const int tile = n_dst >> 8, w = n_dst & 255; n_src = (w < 128) ? (tile * 128 + w) : (DFF + tile * 128 + (w - 128)); }
        else if (kind == 2) {
            const int seg = n_dst >> 10, w = n_dst & 1023;
            const int srcbase = (seg == 0) ? 0 : (seg == 1) ? 1024 : (seg == 2) ? 3072 : (seg == 3) ? 4096 : (seg == 4) ? 5120 : (seg == 5) ? 7176 : (seg == 6) ? 8200 : (seg == 7) ? 2048 : 6144;
            n_src = srcbase + w; }
        transpose_item(W, K, N, WT, kb, n_src, n_dst, scr, lane);
    }
    { float* WF = (float*)(ws + WS_WF); const int gt = blockIdx.x * NT + wave * 64 + lane; if (gt < 8 * 1024) { const int j = gt >> 10, k = gt & 1023; WF[gt] = P.win[(size_t)k * IN_COLS + 7168 + j]; } }
    bf16* XN = (bf16*)(ws + WS_XN); bf16* MEMN = (bf16*)(ws + WS_MEMN);
    for (int m = gw; m < M; m += NGW) rms_row_to_bf16(P.x + (size_t)m * D, P.f1g, XN + (size_t)m * D, lane);
    for (int m = gw; m < MROWS; m += NGW) rms_row_to_bf16(P.mem + (size_t)m * D, P.memkvg, MEMN + (size_t)m * D, lane);
#undef P
}

template <bool HAS_XN, bool FB>
__device__ __forceinline__ void rowpass(const float* xin, const float* Z, const float* gpost, float coef, float* xout, const float* gpre, bf16* XN,
                                        const float* WF, const float* fbias, float* LC, float* BT, LAS unsigned char* lds, int wave) {
    const int lane = fresh_lane(), tid = wave * 64 + lane;
    LAS float* lsf = (LAS float*)lds;
    for (int blk = blockIdx.x; blk < M / 64; blk += gridDim.x) {
        for (int rr = 0; rr < 8; ++rr) {
            const int rl = wave * 8 + rr; const size_t row = (size_t)blk * 64 + rl;
            const f32x4* zr = (const f32x4*)(Z + row * D) + lane; const f32x4* xr = (const f32x4*)(xin + row * D) + lane; f32x4* xo = (f32x4*)(xout + row * D) + lane;
            f32x4 z[4], xv[4]; float s = 0.f;
#pragma unroll
            for (int j = 0; j < 4; ++j) { z[j] = zr[64 * j]; xv[j] = xr[64 * j]; s += (z[j][0] * z[j][0] + z[j][1] * z[j][1]) + (z[j][2] * z[j][2] + z[j][3] * z[j][3]); }
            const float rs = coef / sqrtf(wave_sum(s) * (1.0f / D) + EPS); float s2 = 0.f;
#pragma unroll
            for (int j = 0; j < 4; ++j) { const f32x4 gg = ((const f32x4*)gpost + lane)[64 * j]; xv[j] = xv[j] + z[j] * gg * rs; xo[64 * j] = xv[j];
                s2 += (xv[j][0] * xv[j][0] + xv[j][1] * xv[j][1]) + (xv[j][2] * xv[j][2] + xv[j][3] * xv[j][3]); }
            if (HAS_XN) {
                const float rs2 = 1.0f / sqrtf(wave_sum(s2) * (1.0f / D) + EPS);
                v2u* o8 = (v2u*)(XN + row * D) + lane;
#pragma unroll
                for (int j = 0; j < 4; ++j) { const f32x4 gg = ((const f32x4*)gpre + lane)[64 * j]; xv[j] = xv[j] * gg * rs2; v2u w; w.x = pk2(xv[j][0], xv[j][1]); w.y = pk2(xv[j][2], xv[j][3]); o8[64 * j] = w; }
                if (FB) {
#pragma unroll
                    for (int h = 0; h < 8; ++h) { float d = 0.f;
#pragma unroll
                        for (int j = 0; j < 4; ++j) { const f32x4 w = ((const f32x4*)(WF + h * 1024) + lane)[64 * j]; d += (xv[j][0] * w[0] + xv[j][1] * w[1]) + (xv[j][2] * w[2] + xv[j][3] * w[3]); }
                        d = wave_sum(d) + fbias[h];
                        const float ls = fminf(d, 0.f) - log1pf(__expf(-fabsf(d)));
                        if (lane == 0) lsf[rl * 8 + h] = ls; }
                }
            }
        }
        if (FB) {
            __syncthreads();
            if (tid < 8) { const int h = tid; float run = 0.f;
                for (int r = 0; r < 64; ++r) { run += lsf[r * 8 + h]; LC[((size_t)blk * 64 + r) * 8 + h] = run; }
                BT[blk * 8 + h] = run; }
            __syncthreads();
        }
    }
}

namespace fox {
constexpr int KSTR = 272, VSTR = 144, KBYTES = 64 * KSTR, VBYTES = 128 * VSTR, BUFB = KBYTES + VBYTES, CK_OFF = 2 * BUFB, CPRE_OFF = CK_OFF + 512;
static_assert(CPRE_OFF + 512 <= RING_BYTES, "fox lds");
__device__ __forceinline__ void unit(LAS unsigned char* lds, int u, bf16* QB, const bf16* KB, const bf16* VT, const float* LC, const float* BT, int wave) {
    const int lane = fresh_lane(), tid = wave * 64 + lane;
    const int bh = u & 15, qblk = 31 - (u >> 4), b = bh >> 3, h = bh & 7;
    const int half = lane >> 5, l31 = lane & 31;
    LAS float* ck = (LAS float*)(lds + CK_OFF); LAS float* cpre = (LAS float*)(lds + CPRE_OFF);
    if (tid < 128) { float s = 0.f; for (int j = 0; j < tid; ++j) s += BT[(b * 128 + j) * 8 + h]; cpre[tid] = s; }
    const int qs = qblk * 256 + 32 * wave + l31;
    const size_t qtok = (size_t)b * SEQ + qs;
    bf16x8 qf[8];
#pragma unroll
    for (int ks = 0; ks < 8; ++ks) qf[ks] = *(const bf16x8*)(QB + qtok * 1024 + h * 128 + 16 * ks + 8 * half);
    __syncthreads();
    const float cq = (LC[qtok * 8 + h] + cpre[qs >> 6]) * LOG2E;
    const int ntiles = 4 * (qblk + 1);
    v4u kr[2], vr[2]; float ckr = 0.f;
    const int krow_[2] = {tid >> 4, (tid + 512) >> 4}, kc16 = tid & 15;
    const int vrow_[2] = {tid >> 3, (tid + 512) >> 3}, vc16 = tid & 7;
#define FOX_LOAD(t) do { const size_t k0 = (size_t)b * SEQ + 64 * (t); \
        _Pragma("unroll") for (int i = 0; i < 2; ++i) { kr[i] = *(const v4u*)(KB + (k0 + krow_[i]) * 1024 + h * 128 + 8 * kc16); vr[i] = *(const v4u*)(VT + (size_t)(h * 128 + vrow_[i]) * M + k0 + 8 * vc16); } \
        if (tid < 64) ckr = (LC[(k0 + tid) * 8 + h] + cpre[(t)]) * LOG2E; } while (0)
#define FOX_STORE(buf) do { LAS unsigned char* Kl = lds + (buf) * BUFB; LAS unsigned char* Vl = Kl + KBYTES; \
        _Pragma("unroll") for (int i = 0; i < 2; ++i) { *(LAS v4u*)(Kl + krow_[i] * KSTR + 16 * kc16) = kr[i]; *(LAS v4u*)(Vl + vrow_[i] * VSTR + 16 * vc16) = vr[i]; } \
        if (tid < 64) ck[(buf) * 64 + tid] = ckr; } while (0)
    FOX_LOAD(0); FOX_STORE(0);
    __syncthreads();
    f32x16 o[4];
#pragma unroll
    for (int rb = 0; rb < 4; ++rb)
#pragma unroll
        for (int i = 0; i < 16; ++i) o[rb][i] = 0.f;
    float mrun = -INFINITY, lrun = 0.f;
    const int qmin = qblk * 256 + 32 * wave;
    const int kperm = prow(l31);
    for (int t = 0; t < ntiles; ++t) {
        const int buf = t & 1;
        if (t + 1 < ntiles) FOX_LOAD(t + 1);
        const int kpos0 = 64 * t;
        if (kpos0 <= qmin + 31) {
            const bool full = (kpos0 + 63 <= qmin);
            LAS unsigned char* Kl = lds + buf * BUFB; LAS unsigned char* Vl = Kl + KBYTES;
            f32x16 s[2];
#pragma unroll
            for (int blk = 0; blk < 2; ++blk) {
#pragma unroll
                for (int i = 0; i < 16; ++i) s[blk][i] = 0.f;
#pragma unroll
                for (int ks = 0; ks < 8; ++ks) { const bf16x8 a = *(const LAS bf16x8*)(Kl + (32 * blk + kperm) * KSTR + 32 * ks + 16 * half); s[blk] = MFMA32(a, qf[ks], s[blk]); }
            }
            float mx = -INFINITY;
#pragma unroll
            for (int blk = 0; blk < 2; ++blk)
#pragma unroll
                for (int g = 0; g < 2; ++g) { const int key0 = 32 * blk + 16 * g + 8 * half; const f32x4 c0 = *(const LAS f32x4*)(ck + buf * 64 + key0), c1 = *(const LAS f32x4*)(ck + buf * 64 + key0 + 4);
#pragma unroll
                    for (int e = 0; e < 8; ++e) { const int i = 8 * g + e; float sc = s[blk][i] + (cq - (e < 4 ? c0[e & 3] : c1[e & 3]));
                        if (!full && (kpos0 + key0 + e > qs)) sc = -INFINITY;
                        s[blk][i] = sc; mx = fmaxf(mx, sc); } }
            mx = fmaxf(mx, __shfl_xor(mx, 32));
            const float mnew = fmaxf(mrun, mx), alpha = __builtin_amdgcn_exp2f(mrun - mnew); mrun = mnew;
            float ps = 0.f;
#pragma unroll
            for (int blk = 0; blk < 2; ++blk)
#pragma unroll
                for (int i = 0; i < 16; ++i) { const float p = __builtin_amdgcn_exp2f(s[blk][i] - mnew); s[blk][i] = p; ps += p; }
            lrun = lrun * alpha + ps;
#pragma unroll
            for (int rb = 0; rb < 4; ++rb)
#pragma unroll
                for (int i = 0; i < 16; ++i) o[rb][i] *= alpha;
            bf16x8 pf[4];
#pragma unroll
            for (int k4 = 0; k4 < 4; ++k4) pf[k4] = pack8(s[k4 >> 1], k4 & 1);
#pragma unroll
            for (int rb = 0; rb < 4; ++rb)
#pragma unroll
                for (int k4 = 0; k4 < 4; ++k4) { const bf16x8 a = *(const LAS bf16x8*)(Vl + (32 * rb + l31) * VSTR + 32 * k4 + 16 * half); o[rb] = MFMA32(a, pf[k4], o[rb]); }
        }
        if (t + 1 < ntiles) FOX_STORE(buf ^ 1);
        __syncthreads();
    }
    const float ltot = lrun + __shfl_xor(lrun, 32), inv = 1.0f / ltot;
    bf16* orow = QB + qtok * 1024 + h * 128;
#pragma unroll
    for (int rb = 0; rb < 4; ++rb)
#pragma unroll
        for (int g = 0; g < 4; ++g) { v2u w; w.x = pk2(o[rb][4 * g] * inv, o[rb][4 * g + 1] * inv); w.y = pk2(o[rb][4 * g + 2] * inv, o[rb][4 * g + 3] * inv);
            *(v2u*)(orow + 32 * rb + 8 * g + 4 * half) = w; }
#undef FOX_LOAD
#undef FOX_STORE
}
}

namespace hg {
constexpr int RS = 272;
constexpr int QH_OFF = 0, QE_OFF = 64 * RS, KH_OFF = 2 * 64 * RS, KHT_OFF = 3 * 64 * RS, KHT_RS = 144, ST_OFF = KHT_OFF + 128 * KHT_RS, ST_BYTES = 32 * RS,
              GT_OFF = ST_OFF + 2 * ST_BYTES, D1_OFF = GT_OFF + 2048, D2_OFF = D1_OFF + 512, END_OFF = D2_OFF + 512;
static_assert(END_OFF <= RING_BYTES, "hgrn lds");
__device__ __forceinline__ void unit(LAS unsigned char* lds, int u, const bf16* QA, const bf16* LF, const bf16* IT, bf16* GA, const float* hgg, float* SSQ, int wave) {
    const int lane = fresh_lane(), tid = wave * 64 + lane;
    const int b = u >> 5, h = (u >> 2) & 7, vs = u & 3;
    const int half = lane >> 5, l31 = lane & 31;
    const int c = tid & 127, tg = tid >> 7;
    const size_t tok0 = (size_t)b * SEQ;
    LAS float* GTOT = (LAS float*)(lds + GT_OFF); LAS float* D1 = (LAS float*)(lds + D1_OFF); LAS float* D2 = (LAS float*)(lds + D2_OFF);
    for (int i = tid; i < ST_BYTES / 4; i += NT) ((LAS unsigned*)(lds + ST_OFF))[i] = 0u;
    f32x16 S;
#pragma unroll
    for (int i = 0; i < 16; ++i) S[i] = 0.f;
    unsigned short lfr[16], qr[16]; bf16x8 itf[4];
    const bf16* itrow = IT + (size_t)(h * 128 + 32 * vs + l31) * M + tok0 + 8 * half;
#define HG_LOAD(n) do { const size_t t0 = tok0 + 64 * (n) + 16 * tg; \
        _Pragma("unroll") for (int k = 0; k < 16; ++k) { lfr[k] = LF[(t0 + k) * 1024 + h * 128 + c]; qr[k] = QA[(t0 + k) * 1024 + h * 128 + c]; } \
        if (wave < 6) { _Pragma("unroll") for (int ks = 0; ks < 4; ++ks) itf[ks] = *(const bf16x8*)(itrow + 64 * (n) + 16 * ks); } } while (0)
    HG_LOAD(0);
    __syncthreads();
    for (int n = 0; n < SEQ / 64; ++n) {
        float lf[16], bl[16], qv[16]; float run = 0.f;
#pragma unroll
        for (int k = 0; k < 16; ++k) { lf[k] = bf2f(lfr[k]); qv[k] = bf2f(qr[k]); run += lf[k]; bl[k] = run; }
        bf16x8 itc[4];
#pragma unroll
        for (int ks = 0; ks < 4; ++ks) itc[ks] = itf[ks];
        GTOT[tg * 128 + c] = run;
        if (n + 1 < SEQ / 64) HG_LOAD(n + 1);
        __syncthreads();
        const float g0 = GTOT[c], g1 = GTOT[128 + c], g2 = GTOT[256 + c], g3 = GTOT[384 + c];
        const float off = (tg > 0 ? g0 : 0.f) + (tg > 1 ? g1 : 0.f) + (tg > 2 ? g2 : 0.f);
        const float b31 = g0 + g1, b63 = b31 + g2 + g3;
        unsigned kt[8];
#pragma unroll
        for (int k = 0; k < 16; ++k) { const int t = 16 * tg + k; const float bb = off + bl[k], bp = bb - b31;
            const float qh = qv[k] * __expf(bp), qe = qv[k] * __expf(bb), kk = (1.0f - __expf(lf[k])) * __expf(-bp);
            *(LAS unsigned short*)(lds + QH_OFF + t * RS + 2 * c) = (unsigned short)f2bf(qh);
            *(LAS unsigned short*)(lds + QE_OFF + t * RS + 2 * c) = (unsigned short)f2bf(qe);
            const unsigned kb = f2bf(kk);
            *(LAS unsigned short*)(lds + KH_OFF + t * RS + 2 * c) = (unsigned short)kb;
            if (k & 1) kt[k >> 1] |= kb << 16; else kt[k >> 1] = kb; }
        *(LAS v4u*)(lds + KHT_OFF + c * KHT_RS + 32 * tg) = (v4u){kt[0], kt[1], kt[2], kt[3]};
        *(LAS v4u*)(lds + KHT_OFF + c * KHT_RS + 32 * tg + 16) = (v4u){kt[4], kt[5], kt[6], kt[7]};
        if (tg == 0) { D1[c] = __expf(b31); D2[c] = __expf(b63 - b31); }
        __syncthreads();
        LAS unsigned char* STc = lds + ST_OFF + (n & 1) * ST_BYTES; LAS unsigned char* STn = lds + ST_OFF + ((n + 1) & 1) * ST_BYTES;
        if (wave < 4) {
            const int cc = 32 * wave + l31; const float d1 = D1[cc], d2 = D2[cc];
            f32x16 acc;
#pragma unroll
            for (int i = 0; i < 16; ++i) acc[i] = S[i] * d1;
#pragma unroll
            for (int ks = 0; ks < 4; ++ks) { const bf16x8 bq = *(const LAS bf16x8*)(lds + KHT_OFF + cc * KHT_RS + 32 * ks + 16 * half); acc = MFMA32(itc[ks], bq, acc); }
#pragma unroll
            for (int i = 0; i < 16; ++i) { S[i] = acc[i] * d2; *(LAS unsigned short*)(STn + crow(i, half) * RS + 2 * cc) = (unsigned short)f2bf(S[i]); }
        } else if (wave < 6) {
            const int tb = wave - 4, t = 32 * tb + l31;
            f32x16 o;
#pragma unroll
            for (int i = 0; i < 16; ++i) o[i] = 0.f;
            {
#pragma unroll
                for (int ks = 0; ks < 8; ++ks) { const bf16x8 a = *(const LAS bf16x8*)(STc + l31 * RS + 32 * ks + 16 * half); const bf16x8 bq = *(const LAS bf16x8*)(lds + QE_OFF + t * RS + 32 * ks + 16 * half); o = MFMA32(a, bq, o); }
            }
            bf16x8 qhf[8];
#pragma unroll
            for (int ks = 0; ks < 8; ++ks) qhf[ks] = *(const LAS bf16x8*)(lds + QH_OFF + t * RS + 32 * ks + 16 * half);
            const int kp = prow(l31);
            for (int sb = 0; sb <= tb; ++sb) {
                f32x16 am;
#pragma unroll
                for (int i = 0; i < 16; ++i) am[i] = 0.f;
#pragma unroll
                for (int ks = 0; ks < 8; ++ks) { const bf16x8 a = *(const LAS bf16x8*)(lds + KH_OFF + (32 * sb + kp) * RS + 32 * ks + 16 * half); am = MFMA32(a, qhf[ks], am); }
                if (sb == tb) {
#pragma unroll
                    for (int i = 0; i < 16; ++i) { const int s = 16 * (i >> 3) + 8 * half + (i & 7); if (s > l31) am[i] = 0.f; }
                }
                const bf16x8 p0 = pack8(am, 0), p1 = pack8(am, 1);
                if (sb == 0) { o = MFMA32(itc[0], p0, o); o = MFMA32(itc[1], p1, o); } else { o = MFMA32(itc[2], p0, o); o = MFMA32(itc[3], p1, o); }
            }
            const size_t tok = tok0 + 64 * n + t; float ssq = 0.f;
            bf16* gp = GA + tok * 1024 + h * 128 + 32 * vs;
#pragma unroll
            for (int g = 0; g < 4; ++g) { const int v0 = 8 * g + 4 * half; const v2u gw = *(const v2u*)(gp + v0); const f32x4 gn = *(const f32x4*)(hgg + h * 128 + 32 * vs + v0);
                const float a0 = o[4 * g], a1 = o[4 * g + 1], a2 = o[4 * g + 2], a3 = o[4 * g + 3]; ssq += (a0 * a0 + a1 * a1) + (a2 * a2 + a3 * a3);
                v2u w; w.x = pk2(a0 * gn[0] * bf2f(gw.x & 0xffffu), a1 * gn[1] * bf2f(gw.x >> 16)); w.y = pk2(a2 * gn[2] * bf2f(gw.y & 0xffffu), a3 * gn[3] * bf2f(gw.y >> 16));
                *(v2u*)(gp + v0) = w; }
            ssq += __shfl_xor(ssq, 32);
            if (half == 0) SSQ[tok * 32 + h * 4 + vs] = ssq;
        }
        __syncthreads();
    }
#undef HG_LOAD
}
}

#define XB_TMO      128
#define XB_XCNT(j)  (256  + 64 * (j))
#define XB_XSUB(j)  (1280 + 64 * (j))
#define XB_XGEN(j)  (2304 + 64 * (j))
#define XB_TOP      3328
#define XB_TOPGEN   3392
#define XCD_BAR_WORDS 3456
#define XB_SPIN_CAP (1u << 18)

__device__ __forceinline__ unsigned xb_ld(unsigned* p)              { return __hip_atomic_load(p, __ATOMIC_RELAXED, __HIP_MEMORY_SCOPE_AGENT); }
__device__ __forceinline__ unsigned xb_add(unsigned* p, unsigned v) { return __hip_atomic_fetch_add(p, v, __ATOMIC_RELAXED, __HIP_MEMORY_SCOPE_AGENT); }
__device__ __forceinline__ unsigned xb_xcc_id() { return (unsigned)__builtin_amdgcn_s_getreg((3 << 11) | 20) & 0xFu; }
#define XB_SPIN(cond, bar) do { unsigned _sp = 0; while (cond) { __builtin_amdgcn_s_sleep(1); \
    if ((++_sp & 255u) == 0u) { if (xb_ld(&(bar)[XB_TMO])) break; if (_sp > XB_SPIN_CAP) { atomicAdd(&(bar)[XB_TMO], 1u); break; } } } } while (0)

struct XcdBarrier {
    unsigned* bar; unsigned x;
    volatile LAS unsigned* st;
};

__device__ __forceinline__ XcdBarrier xcd_barrier_post(unsigned* bar, volatile LAS unsigned* st, int tid) {
    XcdBarrier b; b.bar = bar; b.x = xb_xcc_id(); b.st = st;
    if (tid == 0) (void)xb_add(&bar[XB_XCNT(b.x)], 1u);
    return b;
}
__device__ __forceinline__ void xcd_barrier_complete(unsigned* bar, unsigned x, unsigned& nloc, unsigned& nx) {
    const unsigned G = gridDim.x * gridDim.y * gridDim.z;
    unsigned sum, cnt, mine, sp = 0u;
    for (;;) {
        sum = 0u; cnt = 0u; mine = 0u;
#pragma unroll
        for (unsigned j = 0; j < 16; ++j) { const unsigned c = xb_ld(&bar[XB_XCNT(j)]); sum += c; cnt += (c > 0u) ? 1u : 0u; mine = (j == x) ? c : mine; }
        if (sum == G) break;
        __builtin_amdgcn_s_sleep(1);
        if ((++sp & 255u) == 0u) { if (xb_ld(&bar[XB_TMO])) break; if (sp > XB_SPIN_CAP) { atomicAdd(&bar[XB_TMO], 1u); break; } }
    }
    nloc = mine > 0u ? mine : 1u; nx = cnt > 0u ? cnt : 1u;
}

__device__ __forceinline__ void xcd_barrier(const XcdBarrier& b, int tid) {
    asm volatile("s_waitcnt vmcnt(0)" ::: "memory");
    __syncthreads();
    if (tid == 0) {
        unsigned* bar = b.bar;
        __builtin_amdgcn_s_waitcnt(0);
        unsigned nloc = b.st[0], nx = b.st[1];
        if (nloc == 0u) { xcd_barrier_complete(bar, b.x, nloc, nx); b.st[0] = nloc; b.st[1] = nx; }
        const unsigned old = xb_add(&bar[XB_XSUB(b.x)], 1u);
        const unsigned gen = old / nloc;
        if (old + 1u == (gen + 1u) * nloc) {
            __builtin_amdgcn_fence(__ATOMIC_RELEASE, "agent");
            asm volatile("s_waitcnt vmcnt(0)" ::: "memory");
            const unsigned og = xb_add(&bar[XB_TOP], 1u);
            const unsigned tg = og / nx;
            if (og + 1u == (tg + 1u) * nx) xb_add(&bar[XB_TOPGEN], 1u);
            else XB_SPIN(xb_ld(&bar[XB_TOPGEN]) == tg, bar);
            __builtin_amdgcn_fence(__ATOMIC_ACQUIRE, "agent");
            xb_add(&bar[XB_XGEN(b.x)], 1u);
            asm volatile("s_waitcnt vmcnt(0)" ::: "memory");
        } else {
            XB_SPIN(xb_ld(&bar[XB_XGEN(b.x)]) == gen, bar);
            __builtin_amdgcn_fence(__ATOMIC_ACQUIRE, "agent");
            asm volatile("s_waitcnt vmcnt(0)" ::: "memory");
        }
    }
    __syncthreads();
}

typedef const __attribute__((address_space(4))) Ptrs* KPtr;
__global__ void __launch_bounds__(NT, 2) fwd(Ptrs P_unused) {
    KPtr KP = (KPtr)__builtin_amdgcn_kernarg_segment_ptr();
#define P (*KP)
    extern __shared__ __attribute__((aligned(16))) unsigned char lds_raw[];
    LAS unsigned char* lds = (LAS unsigned char*)lds_raw;
    const int wave = __builtin_amdgcn_readfirstlane((int)threadIdx.x >> 6);
#define IDS const int lane = fresh_lane(); const int tid = wave * 64 + lane; (void)tid; (void)lane
    const int G = gridDim.x, bx = blockIdx.x;
    unsigned char* ws = P.ws;
    const int lo = P.ph_lo, hi = P.ph_hi;
#define IN(k) (lo <= (k) && (k) < hi)
#define SEAM(k) do { if (IN(k) && IN((k) + 1)) { if ((k) == 0) cg::this_grid().sync(); else { IDS; xcd_barrier(bar, tid); } } } while (0)
    bf16* XN = (bf16*)(ws + WS_XN); bf16* HID = (bf16*)(ws + WS_HID); float* Z = (float*)(g_buf + GB_Z);
    bf16* QA = (bf16*)(ws + WS_QA); bf16* LFb = (bf16*)(ws + WS_LF); bf16* IT = (bf16*)(ws + WS_IT); bf16* VT = (bf16*)(ws + WS_VT);
    bf16* GA = (bf16*)(g_buf + GB_GA); bf16* QB = (bf16*)(g_buf + GB_QB); bf16* KB = (bf16*)(g_buf + GB_KB); bf16* GT = (bf16*)(g_buf + GB_GT);
    bf16* Y = (bf16*)(ws + WS_Y); bf16* QMH = (bf16*)(ws + WS_QMH); bf16* PP = (bf16*)(ws + WS_P); bf16* OM = (bf16*)(ws + WS_OM);
    float* LC = (float*)(ws + WS_LC); float* BT = (float*)(ws + WS_BT); float* RSTD = (float*)(ws + WS_RSTD); float* SSQ = (float*)(ws + WS_SSQ); const float* WF = (const float*)(ws + WS_WF);
    unsigned* ctl = (unsigned*)(ws + WS_CTL);
    XcdBarrier bar; bar.bar = ctl + CW_BAR; bar.x = 0; bar.st = (volatile LAS unsigned*)(lds + MISC_OFF + 32);
    if (hi - lo > 1) { IDS; if (tid < 2) bar.st[tid] = 0u; __syncthreads(); bar = xcd_barrier_post(ctl + CW_BAR, (volatile LAS unsigned*)(lds + MISC_OFF + 32), tid); }

    if (IN(0)) { p0_prologue(KP, lds, wave); }
    SEAM(0);
    if (IN(1)) {
        { pg8::Gemm g{XN, (const bf16*)(ws + WS_W1A), M, 2 * DFF, D}; pg8::StaticOrder S; S.init(M, 2 * DFF, G, bx); pg8::EpiSwiglu E{HID, DFF};
          pg8::gemm_phase<pg8::EpiSwiglu, pg8::StaticOrder, true, true>(lds, g, S, E, wave); }
        { pg8::Gemm g{(const bf16*)(ws + WS_MEMN), (const bf16*)(ws + WS_WMKV), MROWS, 2 * D, D}; pg8::ListOrder S{MROWS / 256, G >= 144 ? 128 : 0, 16, bx}; pg8::EpiMemKV E{(bf16*)(ws + WS_KM), (bf16*)(ws + WS_VTM)};
          pg8::gemm_phase<pg8::EpiMemKV, pg8::ListOrder, false, true>(lds, g, S, E, wave); }
    }
    SEAM(1);
    if (IN(2)) { pg8::Gemm g{HID, (const bf16*)(ws + WS_W1D), M, D, DFF}; pg8::StaticOrder S; S.init(M, D, G, bx); pg8::EpiF32 E{Z, D};
        pg8::gemm_phase<pg8::EpiF32, pg8::StaticOrder, true, true>(lds, g, S, E, wave); }
    SEAM(2);
    if (IN(3)) rowpass<true, true>(P.x, Z, P.f1pg, 0.5f, P.out, P.mixg, XN, WF, P.fbias, LC, BT, lds, wave);
    SEAM(3);
    if (IN(4)) {
        { pg8::Gemm g{XN, (const bf16*)(ws + WS_WIN), M, 7168, D}; pg8::StaticOrder S; S.init(M, 7168, G, bx);
          pg8::EpiInproj E{QA, LFb, GA, QB, KB, GT, P.lbl, P.bgate, LOG2E * 0.08838834764831845f};
          pg8::gemm_phase<pg8::EpiInproj, pg8::StaticOrder, true, true>(lds, g, S, E, wave); }
        { pg8::Gemm g{(const bf16*)(ws + WS_WIN) + (size_t)7168 * D, XN, 2048, M, D}; pg8::StaticOrder S; S.init(2048, M, G, bx); pg8::EpiBf16P E{IT, M, 1.0f};
          pg8::gemm_phase<pg8::EpiBf16P, pg8::StaticOrder, true, true>(lds, g, S, E, wave); }
    }
    SEAM(4);
    if (IN(5)) {
        if (bx < 64) { hg::unit(lds, bx, QA, LFb, IT, GA, P.hgg, SSQ, wave); }
        if (G < 64) { for (int u = bx + G; u < 64; u += G) hg::unit(lds, u, QA, LFb, IT, GA, P.hgg, SSQ, wave); }
        LAS int* sh = (LAS int*)(lds + MISC_OFF); IDS;
        for (;;) {
            __syncthreads();
            if (tid == 0) sh[0] = (int)atomicAdd(ctl, 1u);
            __syncthreads();
            const int u = sh[0];
            if (u >= 512) break;
            fox::unit(lds, u, QB, KB, VT, LC, BT, wave);
        }
    }
    SEAM(5);
    if (IN(6)) {
        pg8::StaticOrder S; S.init(M, D, G, bx);
        { IDS; pg8::Unit u; for (int i = 0; S.next(i, u); ++i) { const int r = tid >> 1, sub = tid & 1; const float* sp = SSQ + (size_t)(u.pm * 256 + r) * 32 + 16 * sub; float s = 0.f;
#pragma unroll
                for (int j = 0; j < 16; ++j) s += sp[j];
                s += __shfl_xor(s, 1);
                if (sub == 0) RSTD[(size_t)u.pn * M + u.pm * 256 + r] = 1.0f / sqrtf(s * (1.0f / D) + EPS); } }
        __threadfence(); __syncthreads();
        { pg8::Gemm g{GA, (const bf16*)(ws + WS_WBA), M, D, D}; pg8::EpiBranchA E{GT, RSTD}; pg8::gemm_phase<pg8::EpiBranchA, pg8::StaticOrder, true, true>(lds, g, S, E, wave); }
        { pg8::Gemm g{QB, (const bf16*)(ws + WS_WBB), M, D, D}; pg8::EpiBranchB E{GT, Y}; pg8::gemm_phase<pg8::EpiBranchB, pg8::StaticOrder, true, true>(lds, g, S, E, wave); }
    }
    SEAM(6);
    if (IN(7)) { pg8::Gemm g{Y, (const bf16*)(ws + WS_WOUT), M, D, D}; pg8::StaticOrder S; S.init(M, D, G, bx); pg8::EpiF32 E{Z, D}; pg8::gemm_phase<pg8::EpiF32, pg8::StaticOrder, true, true>(lds, g, S, E, wave); }
    SEAM(7);
    if (IN(8)) rowpass<true, false>(P.out, Z, P.mixpg, 1.0f, P.out, P.mempg, XN, nullptr, nullptr, nullptr, nullptr, lds, wave);
    SEAM(8);
    if (IN(9)) { pg8::Gemm g{XN, (const bf16*)(ws + WS_WMQ), M, D, D}; pg8::StaticOrder S; S.init(M, D, G, bx); pg8::EpiHeadSplit E{QMH, M, LOG2E * 0.0625f};
        pg8::gemm_phase<pg8::EpiHeadSplit, pg8::StaticOrder, true, true>(lds, g, S, E, wave); }
    SEAM(9);
    if (IN(10)) {
        pg8::CrossOrder S; S.so.init(M, D, G, bx); S.Mrows = M; S.pm_per_batch = SEQ / 256;
        { pg8::Gemm g{QMH, (const bf16*)(ws + WS_KM), M, D, 256}; pg8::EpiSoftmax E{PP, M}; pg8::gemm_phase<pg8::EpiSoftmax, pg8::CrossOrder, false, true>(lds, g, S, E, wave); }
        __threadfence(); __syncthreads();
        { pg8::Gemm g{PP, (const bf16*)(ws + WS_VTM), M, D, 256}; pg8::EpiBf16P E{OM, D, 1.0f}; pg8::gemm_phase<pg8::EpiBf16P, pg8::CrossOrder, true, true>(lds, g, S, E, wave); }
    }
    SEAM(10);
    if (IN(11)) { pg8::Gemm g{OM, (const bf16*)(ws + WS_WMO), M, D, D}; pg8::StaticOrder S; S.init(M, D, G, bx); pg8::EpiF32 E{Z, D}; pg8::gemm_phase<pg8::EpiF32, pg8::StaticOrder, true, true>(lds, g, S, E, wave); }
    SEAM(11);
    if (IN(12)) rowpass<true, false>(P.out, Z, P.mempostg, 1.0f, P.out, P.f2g, XN, nullptr, nullptr, nullptr, nullptr, lds, wave);
    SEAM(12);
    if (IN(13)) { pg8::Gemm g{XN, (const bf16*)(ws + WS_W2A), M, 2 * DFF, D}; pg8::StaticOrder S; S.init(M, 2 * DFF, G, bx); pg8::EpiSwiglu E{HID, DFF};
        pg8::gemm_phase<pg8::EpiSwiglu, pg8::StaticOrder, true, true>(lds, g, S, E, wave); }
    SEAM(13);
    if (IN(14)) { pg8::Gemm g{HID, (const bf16*)(ws + WS_W2D), M, D, DFF}; pg8::StaticOrder S; S.init(M, D, G, bx); pg8::EpiF32 E{Z, D}; pg8::gemm_phase<pg8::EpiF32, pg8::StaticOrder, true, true>(lds, g, S, E, wave); }
    SEAM(14);
    if (IN(15)) rowpass<false, false>(P.out, Z, P.f2pg, 0.5f, P.out, nullptr, nullptr, nullptr, nullptr, nullptr, nullptr, lds, wave);
#undef IN
#undef SEAM
#undef P
}

extern "C" void kernel_launch(void* const* d_in, const int* in_sizes, int n_in, void* d_out, int out_size, void* d_ws, size_t ws_size, hipStream_t stream) {
    static int grid = 0;
    if (grid == 0) {
        if (n_in != 26 || in_sizes[0] != M * D || out_size != M * D || ws_size < WS_END) { fprintf(stderr, "kernel_launch: unexpected problem (n_in %d, ws %zu)\n", n_in, ws_size); grid = -1; return; }
        int dev = 0, cus = 0, per_cu = 0;
        if (hipGetDevice(&dev) != hipSuccess || hipDeviceGetAttribute(&cus, hipDeviceAttributeMultiprocessorCount, dev) != hipSuccess) { grid = -1; return; }
        if (hipFuncSetAttribute((const void*)fwd, hipFuncAttributeMaxDynamicSharedMemorySize, LDS_BYTES) != hipSuccess) { fprintf(stderr, "kernel_launch: hipFuncSetAttribute failed\n"); grid = -1; return; }
        if (hipOccupancyMaxActiveBlocksPerMultiprocessor(&per_cu, (const void*)fwd, NT, LDS_BYTES) != hipSuccess || per_cu < 1) { fprintf(stderr, "kernel_launch: occupancy query gave %d\n", per_cu); (void)hipGetLastError(); grid = -1; return; }
        grid = cus * 1;
    }
    if (grid < 0) return;
    (void)hipMemsetAsync((char*)d_ws + WS_CTL, 0, CTL_ZERO_BYTES, stream);
    Ptrs p{};
    const float** pf = (const float**)&p;
    for (int i = 0; i < 26; ++i) pf[i] = (const float*)d_in[i];
    p.out = (float*)d_out; p.ws = (unsigned char*)d_ws;
#if ONE_LAUNCH
    p.ph_lo = 0; p.ph_hi = NPHASE;
    void* args[] = {&p};
    hipError_t e = hipLaunchCooperativeKernel((const void*)fwd, dim3(grid), dim3(NT), args, LDS_BYTES, stream);
    if (e != hipSuccess) fprintf(stderr, "cooperative launch failed: %s (grid %d)\n", hipGetErrorString(e), grid);
#else
    for (int k = 0; k < NPHASE; ++k) { p.ph_lo = k; p.ph_hi = k + 1; hipLaunchKernelGGL(fwd, dim3(grid), dim3(NT), LDS_BYTES, stream, p); }
#endif
}
```

```cpp
#include <hip/hip_runtime.h>
#include <hip/hip_cooperative_groups.h>
#include <cstdio>
#include <cstdint>
#include <cmath>
namespace cg = cooperative_groups;
__device__ __forceinline__ int fresh_lane() { int l; asm volatile("v_mbcnt_lo_u32_b32 %0, -1, 0\n\tv_mbcnt_hi_u32_b32 %0, -1, %0" : "=v"(l)); return l; }
namespace pg8 {
#define PG8_LAS __attribute__((address_space(3)))
typedef unsigned short bf16_t;
typedef short bf16x8 __attribute__((ext_vector_type(8)));
typedef float f32x4 __attribute__((ext_vector_type(4)));
typedef unsigned u32x4 __attribute__((ext_vector_type(4)));
constexpr int BM = 256, BK = 64, HALF = 128, HTB = HALF * BK * 2  , STAGE_BYTES = 8 * HTB, NXCD = 8, WGM = 8;

__host__ __device__ __forceinline__ int lds_byte(int r, int c) { const int st = (r >> 4) * 2 + (c >> 5), rr = r & 15, cc = c & 31, ob = rr * 64 + cc * 2; return st * 1024 + (ob ^ (((ob >> 9) & 1) << 5)); }
__host__ __device__ __forceinline__ void stage_rc(int b, int& R, int& C) { const int st = b / 1024, sb = b % 1024, swz = sb ^ (((sb >> 9) & 1) << 5); R = (st >> 1) * 16 + swz / 64; C = (st & 1) * 32 + (swz % 64) / 2; }
__host__ __device__ __forceinline__ int perm32(int rho) { const int n = rho >> 4, i = rho & 15; return 8 * (i >> 2) + 4 * n + (i & 3); }

struct Unit { int pm, pn; };
struct Gemm { const bf16_t* A; const bf16_t* Bt; int M, N, K; };

struct StaticOrder {
    int nM, nN, nwg, G, c;
    __host__ __device__ __forceinline__ void init(int M, int N, int G_, int c_) { nM = M / BM; nN = N / BM; nwg = nM * nN; G = G_; c = c_; }
    __host__ __device__ __forceinline__ bool next(int i, Unit& u) const {
        const long L = (long)i * G + c; if (L >= nwg) return false;
        int wgid = (int)L; { const int q = nwg / NXCD, r = nwg % NXCD, xcd = wgid % NXCD, off = wgid / NXCD; wgid = (xcd < r ? xcd * (q + 1) : r * (q + 1) + (xcd - r) * q) + off; }
        const int nig = WGM * nN, gid = wgid / nig, fm = gid * WGM, gsz = (nM - fm) < WGM ? (nM - fm) : WGM;
        u.pm = fm + ((wgid % nig) % gsz); u.pn = (wgid % nig) / gsz; return true;
    }
    __device__ __forceinline__ const char* pa(const Gemm& g, const Unit& u) const { return (const char*)g.A + (size_t)u.pm * ((size_t)BM * g.K * 2); }
    __device__ __forceinline__ const char* pb(const Gemm& g, const Unit& u) const { return (const char*)g.Bt + (size_t)u.pn * ((size_t)BM * g.K * 2); }
    __device__ __forceinline__ void a_ready(const Unit&) const {}
    __device__ __forceinline__ void done(const Unit&) const {}
};


struct ListOrder {
    int nM, c0, n, c;
    __device__ __forceinline__ bool next(int i, Unit& u) const { const int idx = c - c0; if (i != 0 || idx < 0 || idx >= n) return false; u.pm = idx % nM; u.pn = idx / nM; return true; }
    __device__ __forceinline__ const char* pa(const Gemm& g, const Unit& u) const { return (const char*)g.A + (size_t)u.pm * ((size_t)BM * g.K * 2); }
    __device__ __forceinline__ const char* pb(const Gemm& g, const Unit& u) const { return (const char*)g.Bt + (size_t)u.pn * ((size_t)BM * g.K * 2); }
    __device__ __forceinline__ void a_ready(const Unit&) const {}
    __device__ __forceinline__ void done(const Unit&) const {}
};
struct CrossOrder {
    StaticOrder so; int Mrows, pm_per_batch;
    __device__ __forceinline__ bool next(int i, Unit& u) const { return so.next(i, u); }
    __device__ __forceinline__ const char* pa(const Gemm& g, const Unit& u) const { return (const char*)g.A + ((size_t)u.pn * Mrows + (size_t)u.pm * BM) * ((size_t)g.K * 2); }
    __device__ __forceinline__ const char* pb(const Gemm& g, const Unit& u) const { return (const char*)g.Bt + ((size_t)(u.pn * 2 + u.pm / pm_per_batch) * BM) * ((size_t)g.K * 2); }
    __device__ __forceinline__ void a_ready(const Unit&) const {}
    __device__ __forceinline__ void done(const Unit&) const {}
};

__device__ __forceinline__ unsigned f2bf_(float f) { unsigned u = __builtin_bit_cast(unsigned, f); return (u + 0x7fffu + ((u >> 16) & 1u)) >> 16; }
typedef float f32x2e_ __attribute__((ext_vector_type(2)));
typedef __bf16 bf16x2e_ __attribute__((ext_vector_type(2)));
__device__ __forceinline__ unsigned pk2_(float lo, float hi) { const f32x2e_ v = {lo, hi}; return __builtin_bit_cast(unsigned, __builtin_convertvector(v, bf16x2e_)); }
__device__ __forceinline__ float bf2f_(unsigned v) { return __builtin_bit_cast(float, v << 16); }
typedef unsigned u32x2 __attribute__((ext_vector_type(2)));
__device__ __forceinline__ void st_bf4(bf16_t* p, f32x4 v) { u32x2 w; w.x = pk2_(v[0], v[1]); w.y = pk2_(v[2], v[3]); *(u32x2*)p = w; }
__device__ __forceinline__ f32x4 ld_bf4(const bf16_t* p) { const u32x2 w = *(const u32x2*)p; return (f32x4){bf2f_(w.x & 0xffffu), bf2f_(w.x >> 16), bf2f_(w.y & 0xffffu), bf2f_(w.y >> 16)}; }
__device__ __forceinline__ float sigm(float x) { return 1.0f / (1.0f + __expf(-x)); }
__device__ __forceinline__ float silu_(float x) { return x / (1.0f + __expf(-x)); }

#define PG8_FOREACH_BEGIN \
    _Pragma("unroll") for (int ai = 0; ai < 2; ++ai) _Pragma("unroll") for (int m = 0; m < 4; ++m) { const int row = u.pm * BM + ai * HALF + wr * 64 + m * 16 + fr; \
    _Pragma("unroll") for (int bj = 0; bj < 2; ++bj) _Pragma("unroll") for (int n = 0; n < 2; ++n) { const int col = u.pn * BM + bj * HALF + wc * 32 + n * 16 + 4 * fq; const f32x4 v = acc[ai][bj][m][n];
#define PG8_FOREACH_END } }

struct EpiF32 {
    static constexpr bool PERM = false, AFTER_DRAIN = false; float* O; int ldc;
    __device__ __forceinline__ void operator()(const f32x4 (&acc)[2][2][4][2], const Unit& u, int wr, int wc, int fr, int fq) const {
        PG8_FOREACH_BEGIN *(f32x4*)(O + (size_t)row * ldc + col) = v; PG8_FOREACH_END
    }
};
struct EpiBf16P {
    static constexpr bool PERM = false, AFTER_DRAIN = false; bf16_t* O; int ldc; float sc;
    __device__ __forceinline__ void operator()(const f32x4 (&acc)[2][2][4][2], const Unit& u, int wr, int wc, int fr, int fq) const {
        PG8_FOREACH_BEGIN st_bf4(O + (size_t)row * ldc + col, v * sc); PG8_FOREACH_END
    }
};
struct EpiSwiglu {
    static constexpr bool PERM = false, AFTER_DRAIN = false; bf16_t* O; int ldc;
    __device__ __forceinline__ void operator()(const f32x4 (&acc)[2][2][4][2], const Unit& u, int wr, int wc, int fr, int fq) const {
#pragma unroll
        for (int ai = 0; ai < 2; ++ai)
#pragma unroll
            for (int m = 0; m < 4; ++m) { const int row = u.pm * BM + ai * HALF + wr * 64 + m * 16 + fr;
#pragma unroll
                for (int n = 0; n < 2; ++n) { const int col = u.pn * HALF + wc * 32 + n * 16 + 4 * fq; const f32x4 g = acc[ai][0][m][n], up = acc[ai][1][m][n];
                    f32x4 h; h[0] = silu_(g[0]) * up[0]; h[1] = silu_(g[1]) * up[1]; h[2] = silu_(g[2]) * up[2]; h[3] = silu_(g[3]) * up[3];
                    st_bf4(O + (size_t)row * ldc + col, h); } }
    }
};
struct EpiInproj {
    static constexpr bool PERM = false, AFTER_DRAIN = false;
    bf16_t *QA, *LF, *GA, *QB, *KB, *GT; const float* lbl; const float* bgate; float qscale; int pn0;
    __device__ __forceinline__ void operator()(const f32x4 (&acc)[2][2][4][2], const Unit& u_, int wr, int wc, int fr, int fq) const {
        const Unit u{u_.pm, u_.pn + pn0};
        const int cls = u.pn >> 2;
        if (cls == 0 || cls == 2) { bf16_t* O = cls == 0 ? QA : GA; const int c0 = cls * 1024;
            PG8_FOREACH_BEGIN f32x4 o; o[0] = silu_(v[0]); o[1] = silu_(v[1]); o[2] = silu_(v[2]); o[3] = silu_(v[3]); st_bf4(O + (size_t)row * 1024 + (col - c0), o); PG8_FOREACH_END
        } else if (cls == 1) {
            PG8_FOREACH_BEGIN const int c = col - 1024; const f32x4 l0 = *(const f32x4*)(lbl + c), l1 = *(const f32x4*)(lbl + 1024 + c); f32x4 o;
#pragma unroll
                for (int e = 0; e < 4; ++e) { const float lb = 1.0f / (1.0f + __expf(l1[e] - l0[e])); const float f = lb + (1.0f - lb) * sigm(v[e]); o[e] = __logf(f); }
                st_bf4(LF + (size_t)row * 1024 + c, o); PG8_FOREACH_END
        } else if (cls == 3) {
            PG8_FOREACH_BEGIN st_bf4(QB + (size_t)row * 1024 + (col - 3072), v * qscale); PG8_FOREACH_END
        } else if (cls == 4) {
            PG8_FOREACH_BEGIN st_bf4(KB + (size_t)row * 1024 + (col - 4096), v); PG8_FOREACH_END
        } else {
            PG8_FOREACH_BEGIN const int c = col - 5120; const f32x4 bg = *(const f32x4*)(bgate + c); f32x4 o; o[0] = sigm(v[0] + bg[0]); o[1] = sigm(v[1] + bg[1]); o[2] = sigm(v[2] + bg[2]); o[3] = sigm(v[3] + bg[3]);
                st_bf4(GT + (size_t)row * 2048 + c, o); PG8_FOREACH_END
        }
    }
};
struct EpiBranchA {
    static constexpr bool PERM = false, AFTER_DRAIN = false; bf16_t* GT; const float* rstd;
    __device__ __forceinline__ void operator()(const f32x4 (&acc)[2][2][4][2], const Unit& u, int wr, int wc, int fr, int fq) const {
        const float* rs = rstd + (size_t)u.pn * 16384;
        PG8_FOREACH_BEGIN bf16_t* p = GT + (size_t)row * 2048 + col; const f32x4 g0 = ld_bf4(p); const float r = rs[row]; st_bf4(p, g0 * v * r); PG8_FOREACH_END
    }
};
struct EpiBranchB {
    static constexpr bool PERM = false, AFTER_DRAIN = false; const bf16_t* GT; bf16_t* Y;
    __device__ __forceinline__ void operator()(const f32x4 (&acc)[2][2][4][2], const Unit& u, int wr, int wc, int fr, int fq) const {
        PG8_FOREACH_BEGIN const bf16_t* p = GT + (size_t)row * 2048 + col; const f32x4 t = ld_bf4(p), g1 = ld_bf4(p + 1024); st_bf4(Y + (size_t)row * 1024 + col, t + g1 * v); PG8_FOREACH_END
    }
};
struct EpiHeadSplit {
    static constexpr bool PERM = false, AFTER_DRAIN = false; bf16_t* O; int Mrows; float sc;
    __device__ __forceinline__ void operator()(const f32x4 (&acc)[2][2][4][2], const Unit& u, int wr, int wc, int fr, int fq) const {
        PG8_FOREACH_BEGIN st_bf4(O + ((size_t)u.pn * Mrows + row) * 256 + (col - u.pn * BM), v * sc); PG8_FOREACH_END
    }
};
struct EpiMemKV {
    static constexpr bool PERM = false, AFTER_DRAIN = false; bf16_t *KM, *VTM;
    __device__ __forceinline__ void operator()(const f32x4 (&acc)[2][2][4][2], const Unit& u, int wr, int wc, int fr, int fq) const {
        if (u.pn < 4) { PG8_FOREACH_BEGIN st_bf4(KM + ((size_t)u.pn * 512 + row) * 256 + (col - u.pn * BM), v); PG8_FOREACH_END }
        else { const int h = u.pn - 4;
            PG8_FOREACH_BEGIN const int d = col - u.pn * BM, b = row >> 8, key = row & 255; bf16_t* p = VTM + ((size_t)(h * 2 + b) * 256 + d) * 256 + key;
                p[0] = (bf16_t)f2bf_(v[0]); p[256] = (bf16_t)f2bf_(v[1]); p[512] = (bf16_t)f2bf_(v[2]); p[768] = (bf16_t)f2bf_(v[3]); PG8_FOREACH_END }
    }
};
struct EpiSoftmax {
    static constexpr bool PERM = false, AFTER_DRAIN = true; bf16_t* P; int Mrows;
    __device__ __forceinline__ void fused(f32x4 (&acc)[2][2][4][2], const Unit& u, int wr, int wc, int fr, int fq, PG8_LAS unsigned char* lds, int wid, int lane) const {
        typedef float f32x2v __attribute__((ext_vector_type(2)));
        PG8_LAS f32x2v* X = (PG8_LAS f32x2v*)lds;
        float mx[2][4];
#pragma unroll
        for (int ai = 0; ai < 2; ++ai)
#pragma unroll
            for (int m = 0; m < 4; ++m) { float a = -INFINITY;
#pragma unroll
                for (int bj = 0; bj < 2; ++bj)
#pragma unroll
                    for (int n = 0; n < 2; ++n) { const f32x4 v = acc[ai][bj][m][n]; a = fmaxf(a, fmaxf(fmaxf(v[0], v[1]), fmaxf(v[2], v[3]))); }
                a = fmaxf(a, __shfl_xor(a, 16)); a = fmaxf(a, __shfl_xor(a, 32)); float s = 0.f;
#pragma unroll
                for (int bj = 0; bj < 2; ++bj)
#pragma unroll
                    for (int n = 0; n < 2; ++n) { const f32x4 v = acc[ai][bj][m][n]; s += (__builtin_amdgcn_exp2f(v[0] - a) + __builtin_amdgcn_exp2f(v[1] - a)) + (__builtin_amdgcn_exp2f(v[2] - a) + __builtin_amdgcn_exp2f(v[3] - a)); }
                s += __shfl_xor(s, 16); s += __shfl_xor(s, 32); mx[ai][m] = a;
                if (fq == 0) X[(ai * HALF + wr * 64 + m * 16 + fr) * 4 + wc] = (f32x2v){a, s}; }
        asm volatile("s_waitcnt lgkmcnt(0)" ::: "memory"); __builtin_amdgcn_s_barrier(); asm volatile("" ::: "memory");
#pragma unroll
        for (int ai = 0; ai < 2; ++ai)
#pragma unroll
            for (int m = 0; m < 4; ++m) { const int rl = ai * HALF + wr * 64 + m * 16 + fr; const f32x2v a = X[rl * 4 + 0], b = X[rl * 4 + 1], c = X[rl * 4 + 2], d = X[rl * 4 + 3];
                const float gm = fmaxf(fmaxf(a.x, b.x), fmaxf(c.x, d.x));
                const float gs = (a.y * __builtin_amdgcn_exp2f(a.x - gm) + b.y * __builtin_amdgcn_exp2f(b.x - gm)) + (c.y * __builtin_amdgcn_exp2f(c.x - gm) + d.y * __builtin_amdgcn_exp2f(d.x - gm));
                const float inv = 1.0f / gs; const int row = u.pm * BM + rl;
#pragma unroll
                for (int bj = 0; bj < 2; ++bj)
#pragma unroll
                    for (int n = 0; n < 2; ++n) { const int cl = bj * HALF + wc * 32 + n * 16 + 4 * fq; const f32x4 v = acc[ai][bj][m][n]; f32x4 p;
                        p[0] = __builtin_amdgcn_exp2f(v[0] - gm) * inv; p[1] = __builtin_amdgcn_exp2f(v[1] - gm) * inv; p[2] = __builtin_amdgcn_exp2f(v[2] - gm) * inv; p[3] = __builtin_amdgcn_exp2f(v[3] - gm) * inv;
                        st_bf4(P + ((size_t)u.pn * Mrows + row) * 256 + cl, p); } }
        (void)mx; (void)wid; (void)lane;
    }
};
template <class Epi, class Sched, bool ALIGN_EPI = false, bool SP2 = false>
__device__ __forceinline__ void gemm_phase(PG8_LAS unsigned char* lds, const Gemm g, const Sched& S, const Epi& E, const int wave_s) {
    const int lane = fresh_lane(), wid = wave_s, tid = wid * 64 + lane, wr = wid >> 2, wc = wid & 3, fr = lane & 15, fq = lane >> 4;
    const int K = g.K, nt = K / BK;
    unsigned voffA[2], voffB[2];
#pragma unroll
    for (int i = 0; i < 2; ++i) { int R, C; stage_rc(tid * 16 + i * 8192, R, C); const int Rb = Epi::PERM ? ((R & ~31) + perm32(R & 31)) : R;
        voffA[i] = (unsigned)(R * K + C) * 2u; voffB[i] = (unsigned)(Rb * K + C) * 2u; }
    const size_t kstep = (size_t)(BK * 2);
    const size_t hstep = (size_t)HALF * K * 2;
    const size_t tstep = 2 * hstep;
    const unsigned ldsw = (unsigned)wid * 1024u;
    const int aoff = lds_byte(wr * 64 + fr, fq * 8), boff = lds_byte(wc * 32 + fr, fq * 8);
#define PG8_SA(b, h) (((b) * 2 + (h)) * HTB)
#define PG8_SB(b, h) ((4 + (b) * 2 + (h)) * HTB)
#define PG8_STAGE(bufoff, gbase, voff) do { _Pragma("unroll") for (int _i = 0; _i < 2; ++_i) \
        __builtin_amdgcn_global_load_lds((const unsigned*)((const char*)(gbase) + (voff)[_i]), (PG8_LAS unsigned*)(lds + (bufoff) + ldsw + _i * 8192), 16, 0, 0); } while (0)
#define PG8_LDA(dst, b, h) do { _Pragma("unroll") for (int m = 0; m < 4; ++m) _Pragma("unroll") for (int k = 0; k < 2; ++k) dst[m][k] = *(const PG8_LAS bf16x8*)(lds + PG8_SA(b, h) + aoff + m * 2048 + k * 1024); } while (0)
#define PG8_LDB(dst, b, h) do { _Pragma("unroll") for (int n = 0; n < 2; ++n) _Pragma("unroll") for (int k = 0; k < 2; ++k) dst[n][k] = *(const PG8_LAS bf16x8*)(lds + PG8_SB(b, h) + boff + n * 2048 + k * 1024); } while (0)
#define PG8_MMA(ai, bj, At, Bt) do { __builtin_amdgcn_s_setprio(1); _Pragma("unroll") for (int m = 0; m < 4; ++m) _Pragma("unroll") for (int n = 0; n < 2; ++n) _Pragma("unroll") for (int k = 0; k < 2; ++k) \
        acc[ai][bj][m][n] = __builtin_amdgcn_mfma_f32_16x16x32_bf16(Bt[n][k], At[m][k], acc[ai][bj][m][n], 0, 0, 0); __builtin_amdgcn_s_setprio(0); } while (0)
#define PG8_WAIT_V(n) asm volatile("s_waitcnt vmcnt(" #n ")" ::: "memory")
#define PG8_WAIT_L(n) asm volatile("s_waitcnt lgkmcnt(" #n ")" ::: "memory")
#define PG8_BAR __builtin_amdgcn_s_barrier()
#define PG8_SCHED __builtin_amdgcn_sched_barrier(0)
    Unit cur, nxt; int ui = 0;
    if (!S.next(0, cur)) return;
    f32x4 acc[2][2][4][2];
#pragma unroll
    for (int a = 0; a < 2; ++a)
#pragma unroll
        for (int b = 0; b < 2; ++b)
#pragma unroll
            for (int m = 0; m < 4; ++m)
#pragma unroll
                for (int n = 0; n < 2; ++n) acc[a][b][m][n] = (f32x4){0.f, 0.f, 0.f, 0.f};
    bf16x8 At[4][2], B0[2][2], B1[2][2];
    const char* cA = S.pa(g, cur); const char* cB = S.pb(g, cur);
    S.a_ready(cur);
    if constexpr (SP2) {
        PG8_STAGE(PG8_SB(0, 0), cB, voffB); PG8_STAGE(PG8_SB(0, 1), cB + hstep, voffB); PG8_STAGE(PG8_SA(0, 0), cA, voffA); PG8_STAGE(PG8_SA(0, 1), cA + hstep, voffA);
        if (wr == 1) PG8_BAR;
        PG8_WAIT_V(2); PG8_BAR;
        PG8_STAGE(PG8_SB(1, 0), cB + kstep, voffB); PG8_STAGE(PG8_SA(1, 0), cA + kstep, voffA); PG8_STAGE(PG8_SB(1, 1), cB + hstep + kstep, voffB);
        PG8_WAIT_V(6); PG8_BAR;
    } else {
        PG8_STAGE(PG8_SB(0, 0), cB, voffB); PG8_STAGE(PG8_SA(0, 0), cA, voffA); PG8_STAGE(PG8_SB(0, 1), cB + hstep, voffB); PG8_STAGE(PG8_SA(0, 1), cA + hstep, voffA);
        if (wr == 1) PG8_BAR;
        PG8_WAIT_V(4); PG8_BAR;
        PG8_STAGE(PG8_SB(1, 0), cB + kstep, voffB); PG8_STAGE(PG8_SA(1, 0), cA + kstep, voffA); PG8_STAGE(PG8_SB(1, 1), cB + hstep + kstep, voffB);
        PG8_WAIT_V(6); PG8_BAR;
    }
    for (;;) {
        const bool has_next = S.next(ui + 1, nxt);
        const char* nA = has_next ? S.pa(g, nxt) : cA; const char* nB = has_next ? S.pb(g, nxt) : cB;
        for (int t = 0; t < nt; t += 2) {
            const bool last = (t == nt - 2);
            const char* a1 = cA + (size_t)(t + 1) * kstep;
            const char* a2 = last ? nA : cA + (size_t)(t + 2) * kstep; const char* b2 = last ? nB : cB + (size_t)(t + 2) * kstep;
            const char* a3 = a2 + kstep; const char* b3 = b2 + kstep;
            if (last && has_next) S.a_ready(nxt);
            if constexpr (SP2) {
            PG8_LDB(B0, 0, 0); PG8_LDB(B1, 0, 1); PG8_SCHED; PG8_LDA(At, 0, 0); PG8_STAGE(PG8_SA(1, 1), a1 + hstep, voffA);
            PG8_WAIT_V(8); PG8_WAIT_L(0); PG8_BAR; PG8_MMA(0, 0, At, B0); PG8_MMA(0, 1, At, B1); PG8_BAR; PG8_SCHED;
            PG8_LDA(At, 0, 1); PG8_STAGE(PG8_SB(0, 0), b2, voffB); PG8_STAGE(PG8_SB(0, 1), b2 + hstep, voffB); PG8_STAGE(PG8_SA(0, 0), a2, voffA);
            PG8_WAIT_V(8); PG8_WAIT_L(0); PG8_BAR; PG8_MMA(1, 0, At, B0); PG8_MMA(1, 1, At, B1); PG8_BAR; PG8_SCHED;
            PG8_LDB(B0, 1, 0); PG8_LDB(B1, 1, 1); PG8_SCHED; PG8_LDA(At, 1, 0); PG8_STAGE(PG8_SA(0, 1), a2 + hstep, voffA);
            PG8_WAIT_V(8); PG8_WAIT_L(0); PG8_BAR; PG8_MMA(0, 0, At, B0); PG8_MMA(0, 1, At, B1); PG8_BAR; PG8_SCHED;
            PG8_LDA(At, 1, 1); PG8_STAGE(PG8_SB(1, 0), b3, voffB); PG8_STAGE(PG8_SB(1, 1), b3 + hstep, voffB); PG8_STAGE(PG8_SA(1, 0), a3, voffA);
            PG8_WAIT_V(8); PG8_WAIT_L(0); PG8_BAR; PG8_MMA(1, 0, At, B0); PG8_MMA(1, 1, At, B1); PG8_BAR; PG8_SCHED;
            } else {
            PG8_LDB(B0, 0, 0); PG8_SCHED; PG8_LDA(At, 0, 0); PG8_STAGE(PG8_SA(1, 1), a1 + hstep, voffA);
            PG8_WAIT_L(8); PG8_BAR; PG8_WAIT_L(0); PG8_MMA(0, 0, At, B0); PG8_BAR; PG8_SCHED;
            PG8_LDB(B1, 0, 1); PG8_STAGE(PG8_SB(0, 0), b2, voffB);
            PG8_BAR; PG8_WAIT_L(0); PG8_MMA(0, 1, At, B1); PG8_BAR;
            PG8_LDA(At, 0, 1); PG8_STAGE(PG8_SA(0, 0), a2, voffA);
            PG8_BAR; PG8_WAIT_L(0); PG8_MMA(1, 0, At, B0); PG8_BAR; PG8_SCHED;
            PG8_STAGE(PG8_SB(0, 1), b2 + hstep, voffB);
            PG8_WAIT_V(6); PG8_BAR; PG8_MMA(1, 1, At, B1); PG8_BAR;
            PG8_LDB(B0, 1, 0); PG8_SCHED; PG8_LDA(At, 1, 0); PG8_STAGE(PG8_SA(0, 1), a2 + hstep, voffA);
            PG8_WAIT_L(8); PG8_BAR; PG8_WAIT_L(0); PG8_MMA(0, 0, At, B0); PG8_BAR; PG8_SCHED;
            PG8_LDB(B1, 1, 1); PG8_STAGE(PG8_SB(1, 0), b3, voffB);
            PG8_BAR; PG8_WAIT_L(0); PG8_MMA(0, 1, At, B1); PG8_BAR;
            PG8_LDA(At, 1, 1); PG8_STAGE(PG8_SA(1, 0), a3, voffA);
            PG8_BAR; PG8_WAIT_L(0); PG8_MMA(1, 0, At, B0); PG8_BAR; PG8_SCHED;
            PG8_STAGE(PG8_SB(1, 1), b3 + hstep, voffB);
            PG8_WAIT_V(6); PG8_BAR; PG8_MMA(1, 1, At, B1); PG8_BAR;
            }
        }
        if constexpr (ALIGN_EPI) { if (wr == 0) PG8_BAR; }
        if constexpr (!Epi::AFTER_DRAIN) { E(acc, cur, wr, wc, fr, fq); S.done(cur); }
        if (!has_next) break;
#pragma unroll
        for (int a = 0; a < 2; ++a)
#pragma unroll
            for (int b = 0; b < 2; ++b)
#pragma unroll
                for (int m = 0; m < 4; ++m)
#pragma unroll
                    for (int n = 0; n < 2; ++n) acc[a][b][m][n] = (f32x4){0.f, 0.f, 0.f, 0.f};
        cur = nxt; cA = nA; cB = nB; ++ui;
        if constexpr (ALIGN_EPI) { if (wr == 1) PG8_BAR; }
    }
    PG8_WAIT_V(0);
    if constexpr (!ALIGN_EPI) { if (wr == 0) PG8_BAR; }
    PG8_BAR;
    if constexpr (Epi::AFTER_DRAIN) { E.fused(acc, cur, wr, wc, fr, fq, lds, wid, lane); S.done(cur); }
#undef PG8_SA
#undef PG8_SB
#undef PG8_STAGE
#undef PG8_LDA
#undef PG8_LDB
#undef PG8_MMA
#undef PG8_WAIT_V
#undef PG8_WAIT_L
#undef PG8_BAR
#undef PG8_SCHED
}
}

constexpr int NW = 8, NT = NW * 64;
constexpr int BATCH = 2, SEQ = 8192, D = 1024, M = BATCH * SEQ, DFF = 2816, NH = 8, DH = 128, MEMLEN = 256, MROWS = BATCH * MEMLEN;
constexpr int IN_COLS = 9224;
constexpr float EPS = 1e-6f, LOG2E = 1.4426950408889634f;
constexpr int LDS_BYTES = 147456, RING_BYTES = 131072, MISC_OFF = RING_BYTES;
constexpr int NPHASE = 17;
#ifndef FOX_SKIP
#define FOX_SKIP 1
#endif
#ifndef ONE_LAUNCH
#define ONE_LAUNCH 1
#endif

constexpr size_t MiB = 1u << 20;
constexpr size_t WS_CTL = 0, CTL_ZERO_BYTES = 65536;
constexpr int CW_BAR = 4096;
constexpr size_t WS_WF = 1 * MiB;
constexpr size_t WS_LC = 1 * MiB + 64 * 1024;
constexpr size_t WS_BT = 1 * MiB + 640 * 1024;
constexpr size_t WS_RSTD = 1 * MiB + 704 * 1024;
constexpr size_t WS_KMAXP = 1 * MiB + 960 * 1024;
constexpr size_t WS_SSQ = 2 * MiB;
constexpr size_t WS_MEMN = 4 * MiB;
constexpr size_t WS_KM = 5 * MiB;
constexpr size_t WS_VTM = 6 * MiB;
constexpr size_t WS_W1A = 8 * MiB, WS_W1D = WS_W1A + 11 * MiB, WS_WIN = WS_W1D + 11 * MiB / 2, WS_WBA = WS_WIN + 18 * MiB, WS_WBB = WS_WBA + 2 * MiB, WS_WOUT = WS_WBB + 2 * MiB,
                 WS_WMQ = WS_WOUT + 2 * MiB, WS_WMO = WS_WMQ + 2 * MiB, WS_WMKV = WS_WMO + 2 * MiB, WS_W2A = WS_WMKV + 4 * MiB, WS_W2D = WS_W2A + 11 * MiB, WS_WEND = WS_W2D + 11 * MiB / 2;
static_assert(WS_WEND == 73 * MiB, "weights map");
constexpr size_t WS_XN = 74 * MiB;
constexpr size_t WS_R = 106 * MiB;
constexpr size_t WS_HID = WS_R;
constexpr size_t WS_QA = WS_R, WS_LF = WS_R + 32 * MiB, WS_IT = WS_R + 64 * MiB, WS_VT = WS_R + 96 * MiB;
constexpr size_t WS_Y = WS_R, WS_QMH = WS_R + 32 * MiB, WS_P = WS_R + 64 * MiB, WS_OM = WS_R + 96 * MiB;
constexpr size_t WS_D1 = 234 * MiB, WS_D2 = 235 * MiB;
constexpr size_t WS_END = 256 * MiB;
constexpr size_t GB_Z = 0, GB_GA = 0, GB_QB = 32 * MiB, GB_KB = 64 * MiB, GB_GT = 96 * MiB, GB_KHT = 160 * MiB, GB_BYTES = 192 * MiB;
__device__ __attribute__((aligned(256))) unsigned char g_buf[GB_BYTES];

#define LAS __attribute__((address_space(3)))
typedef unsigned short bf16;
typedef unsigned v4u __attribute__((ext_vector_type(4)));
typedef unsigned v2u __attribute__((ext_vector_type(2)));
typedef float f32x4 __attribute__((ext_vector_type(4)));
typedef float f32x16 __attribute__((ext_vector_type(16)));
typedef short bf16x8 __attribute__((ext_vector_type(8)));
__device__ __forceinline__ unsigned f2bf(float f) { unsigned u = __builtin_bit_cast(unsigned, f); return (u + 0x7fffu + ((u >> 16) & 1u)) >> 16; }
typedef float f32x2_ __attribute__((ext_vector_type(2)));
typedef __bf16 bf16x2_ __attribute__((ext_vector_type(2)));
__device__ __forceinline__ unsigned pk2(float lo, float hi) { const f32x2_ v = {lo, hi}; return __builtin_bit_cast(unsigned, __builtin_convertvector(v, bf16x2_)); }
__device__ __forceinline__ float bf2f(unsigned v) { return __builtin_bit_cast(float, v << 16); }
__device__ __forceinline__ float wave_sum(float v) {
#pragma unroll
    for (int o = 1; o < 64; o <<= 1) v += __shfl_xor(v, o);
    return v;
}
#define MFMA32(a, b, c) __builtin_amdgcn_mfma_f32_32x32x16_bf16((a), (b), (c), 0, 0, 0)
__device__ __forceinline__ int crow(int reg, int h) { return (reg & 3) + 8 * (reg >> 2) + 4 * h; }
__device__ __forceinline__ int prow(int m) { return (m & 0x13) | ((m & 4) << 1) | ((m & 8) >> 1); }
__device__ __forceinline__ bf16x8 pack8(const f32x16& x, int s) {
    v4u p; p.x = pk2(x[8 * s + 0], x[8 * s + 1]); p.y = pk2(x[8 * s + 2], x[8 * s + 3]); p.z = pk2(x[8 * s + 4], x[8 * s + 5]); p.w = pk2(x[8 * s + 6], x[8 * s + 7]);
    return __builtin_bit_cast(bf16x8, p);
}

struct Ptrs {
    const float *x, *mem, *f1g, *f1wi, *f1wd, *f1pg, *mixg, *win, *lbl, *hgg, *fbias, *wba, *wbb, *bgate, *wout, *mixpg, *mempg, *memkvg, *wmq, *wmkv, *wmo, *mempostg, *f2g, *f2wi, *f2wd, *f2pg;
    float* out; unsigned char* ws; int ph_lo, ph_hi;
};

__device__ __forceinline__ void transpose_item(const float* W, int K, int N, bf16* WT, int kb, int n_src, int n_dst, LAS float* scr, int lane) {
    const int k0 = 64 * kb;
#pragma unroll 8
    for (int i = 0; i < 32; ++i) { const int kk = 2 * i + (lane >> 5); scr[kk * 33 + (lane & 31)] = W[(size_t)(k0 + kk) * N + n_src + (lane & 31)]; }
    asm volatile("s_waitcnt lgkmcnt(0)" ::: "memory");
    const int c = lane & 7;
#pragma unroll
    for (int j = 0; j < 4; ++j) { const int n = (lane >> 3) + 8 * j; const LAS float* s = scr + (8 * c) * 33 + n;
        v4u o; o.x = pk2(s[0 * 33], s[1 * 33]); o.y = pk2(s[2 * 33], s[3 * 33]); o.z = pk2(s[4 * 33], s[5 * 33]); o.w = pk2(s[6 * 33], s[7 * 33]);
        *(v4u*)(WT + (size_t)(n_dst + n) * K + k0 + 8 * c) = o; }
    asm volatile("s_waitcnt lgkmcnt(0)" ::: "memory");
}
__device__ __forceinline__ void rms_row_to_bf16(const float* xrow, const float* g, bf16* orow, int lane) {
    const f32x4* xr = (const f32x4*)xrow + lane; const f32x4* gr = (const f32x4*)g + lane;
    f32x4 v[4]; float s = 0.f;
#pragma unroll
    for (int j = 0; j < 4; ++j) { v[j] = xr[64 * j]; s += (v[j][0] * v[j][0] + v[j][1] * v[j][1]) + (v[j][2] * v[j][2] + v[j][3] * v[j][3]); }
    const float rs = 1.0f / sqrtf(wave_sum(s) * (1.0f / D) + EPS);
    v2u* o8 = (v2u*)orow + lane;
#pragma unroll
    for (int j = 0; j < 4; ++j) { const f32x4 gg = gr[64 * j]; v2u w; w.x = pk2(v[j][0] * rs * gg[0], v[j][1] * rs * gg[1]); w.y = pk2(v[j][2] * rs * gg[2], v[j][3] * rs * gg[3]); o8[64 * j] = w; }
}

struct TItem { const float* W; int K, N; bf16* WT; int nblk; int kind; };
typedef const __attribute__((address_space(4))) Ptrs* KPtr0;
__device__ __forceinline__ void p0_prologue(KPtr0 KP, LAS unsigned char* lds, int wave) {
#define P (*KP)
    const int lane = fresh_lane();
    unsigned char* ws = P.ws;
    LAS float* scr = (LAS float*)(lds + wave * 16384);
    const int gw = blockIdx.x * NW + wave, NGW = gridDim.x * NW;
    constexpr int I_1A = 16 * 176, I_1D = 44 * 32, I_IN = 16 * 288, I_SQ = 16 * 32, I_KV = 16 * 64;
    constexpr int NITEMS = 2 * I_1A + 2 * I_1D + I_IN + 5 * I_SQ + I_KV;
    for (int it = gw; it < NITEMS; it += NGW) {
        int r = it; const float* W; int K, N, kind; bf16* WT;
        if (r < I_1A) { W = P.f1wi; K = D; N = 2 * DFF; WT = (bf16*)(ws + WS_W1A); kind = 1; }
        else if ((r -= I_1A) < I_1A) { W = P.f2wi; K = D; N = 2 * DFF; WT = (bf16*)(ws + WS_W2A); kind = 1; }
        else if ((r -= I_1A) < I_1D) { W = P.f1wd; K = DFF; N = D; WT = (bf16*)(ws + WS_W1D); kind = 0; }
        else if ((r -= I_1D) < I_1D) { W = P.f2wd; K = DFF; N = D; WT = (bf16*)(ws + WS_W2D); kind = 0; }
        else if ((r -= I_1D) < I_IN) { W = P.win; K = D; N = IN_COLS; WT = (bf16*)(ws + WS_WIN); kind = 2; }
        else if ((r -= I_IN) < I_SQ) { W = P.wba; K = D; N = D; WT = (bf16*)(ws + WS_WBA); kind = 0; }
        else if ((r -= I_SQ) < I_SQ) { W = P.wbb; K = D; N = D; WT = (bf16*)(ws + WS_WBB); kind = 0; }
        else if ((r -= I_SQ) < I_SQ) { W = P.wout; K = D; N = D; WT = (bf16*)(ws + WS_WOUT); kind = 0; }
        else if ((r -= I_SQ) < I_SQ) { W = P.wmq; K = D; N = D; WT = (bf16*)(ws + WS_WMQ); kind = 0; }
        else if ((r -= I_SQ) < I_SQ) { W = P.wmo; K = D; N = D; WT = (bf16*)(ws + WS_WMO); kind = 0; }
        else { r -= I_SQ; W = P.wmkv; K = D; N = 2 * D; WT = (bf16*)(ws + WS_WMKV); kind = 0; }
        int ndb = (kind == 2) ? 288 : N / 32;
        const int kb = r / ndb, nb = r % ndb; const int n_dst = 32 * nb; int n_src = n_dst;
        if (kind == 1) { const int tile = n_dst >> 8, w = n_dst & 255; n_src = (w < 128) ? (tile * 128 + w) : (DFF + tile * 128 + (w - 128)); }
        else if (kind == 2) {
            const int seg = n_dst >> 10, w = n_dst & 1023;
            const int srcbase = (seg == 0) ? 0 : (seg == 1) ? 1024 : (seg == 2) ? 3072 : (seg == 3) ? 4096 : (seg == 4) ? 5120 : (seg == 5) ? 7176 : (seg == 6) ? 8200 : (seg == 7) ? 2048 : 6144;
            n_src = srcbase + w; }
        transpose_item(W, K, N, WT, kb, n_src, n_dst, scr, lane);
    }
    { float* WF = (float*)(ws + WS_WF); const int gt = blockIdx.x * NT + wave * 64 + lane; if (gt < 8 * 1024) { const int j = gt >> 10, k = gt & 1023; WF[gt] = P.win[(size_t)k * IN_COLS + 7168 + j]; } }
    bf16* XN = (bf16*)(ws + WS_XN); bf16* MEMN = (bf16*)(ws + WS_MEMN);
    for (int m = gw; m < M; m += NGW) rms_row_to_bf16(P.x + (size_t)m * D, P.f1g, XN + (size_t)m * D, lane);
    for (int m = gw; m < MROWS; m += NGW) rms_row_to_bf16(P.mem + (size_t)m * D, P.memkvg, MEMN + (size_t)m * D, lane);
#undef P
}

template <bool HAS_XN, bool FB>
__device__ __forceinline__ void rowpass(const float* xin, const float* Z, const float* gpost, float coef, float* xout, const float* gpre, bf16* XN,
                                        const float* WF, const float* fbias, float* LC, float* BT, LAS unsigned char* lds, int wave) {
    const int lane = fresh_lane(), tid = wave * 64 + lane;
    LAS float* lsf = (LAS float*)lds;
    for (int blk = blockIdx.x; blk < M / 64; blk += gridDim.x) {
        for (int rr = 0; rr < 8; ++rr) {
            const int rl = wave * 8 + rr; const size_t row = (size_t)blk * 64 + rl;
            const f32x4* zr = (const f32x4*)(Z + row * D) + lane; const f32x4* xr = (const f32x4*)(xin + row * D) + lane; f32x4* xo = (f32x4*)(xout + row * D) + lane;
            f32x4 z[4], xv[4]; float s = 0.f;
#pragma unroll
            for (int j = 0; j < 4; ++j) { z[j] = zr[64 * j]; xv[j] = xr[64 * j]; s += (z[j][0] * z[j][0] + z[j][1] * z[j][1]) + (z[j][2] * z[j][2] + z[j][3] * z[j][3]); }
            const float rs = coef / sqrtf(wave_sum(s) * (1.0f / D) + EPS); float s2 = 0.f;
#pragma unroll
            for (int j = 0; j < 4; ++j) { const f32x4 gg = ((const f32x4*)gpost + lane)[64 * j]; xv[j] = xv[j] + z[j] * gg * rs; xo[64 * j] = xv[j];
                s2 += (xv[j][0] * xv[j][0] + xv[j][1] * xv[j][1]) + (xv[j][2] * xv[j][2] + xv[j][3] * xv[j][3]); }
            if (HAS_XN) {
                const float rs2 = 1.0f / sqrtf(wave_sum(s2) * (1.0f / D) + EPS);
                v2u* o8 = (v2u*)(XN + row * D) + lane;
#pragma unroll
                for (int j = 0; j < 4; ++j) { const f32x4 gg = ((const f32x4*)gpre + lane)[64 * j]; xv[j] = xv[j] * gg * rs2; v2u w; w.x = pk2(xv[j][0], xv[j][1]); w.y = pk2(xv[j][2], xv[j][3]); o8[64 * j] = w; }
                if (FB) {
#pragma unroll
                    for (int h = 0; h < 8; ++h) { float d = 0.f;
#pragma unroll
                        for (int j = 0; j < 4; ++j) { const f32x4 w = ((const f32x4*)(WF + h * 1024) + lane)[64 * j]; d += (xv[j][0] * w[0] + xv[j][1] * w[1]) + (xv[j][2] * w[2] + xv[j][3] * w[3]); }
                        d = wave_sum(d) + fbias[h];
                        const float ls = fminf(d, 0.f) - log1pf(__expf(-fabsf(d)));
                        if (lane == 0) lsf[rl * 8 + h] = ls; }
                }
            }
        }
        if (FB) {
            __syncthreads();
            if (tid < 8) { const int h = tid; float run = 0.f;
                for (int r = 0; r < 64; ++r) { run += lsf[r * 8 + h]; LC[((size_t)blk * 64 + r) * 8 + h] = run; }
                BT[blk * 8 + h] = run; }
            __syncthreads();
        }
    }
}

namespace fox {
constexpr int KSTR = 272, VSTR = 144, KBYTES = 64 * KSTR, VBYTES = 128 * VSTR, BUFB = KBYTES + VBYTES, CK_OFF = 2 * BUFB, CPRE_OFF = CK_OFF + 512, CE_OFF = CPRE_OFF + 512, RED_OFF = CE_OFF + 512, FLG_OFF = RED_OFF + 512, KMX_OFF = FLG_OFF + 64;
static_assert(KMX_OFF + 16 <= RING_BYTES, "fox lds");
__device__ __forceinline__ void unit(LAS unsigned char* lds, int u, bf16* QB, const bf16* KB, const bf16* VT, const float* LC, const float* BT, const float* KMAXP, int wave) {
    const int lane = fresh_lane(), tid = wave * 64 + lane;
    const int bh = u & 15, qblk = 31 - (u >> 4), b = bh >> 3, h = bh & 7;
    const int half = lane >> 5, l31 = lane & 31;
    LAS float* ck = (LAS float*)(lds + CK_OFF); LAS float* cpre = (LAS float*)(lds + CPRE_OFF); LAS float* ce = (LAS float*)(lds + CE_OFF); LAS float* red = (LAS float*)(lds + RED_OFF);
    LAS unsigned* flg = (LAS unsigned*)(lds + FLG_OFF); LAS float* kmx = (LAS float*)(lds + KMX_OFF);
    const int ntiles = 4 * (qblk + 1);
    if (tid < 128) { float s = 0.f; for (int j = 0; j < tid; ++j) s += BT[(b * 128 + j) * 8 + h]; cpre[tid] = s; red[tid] = KMAXP[(b * 128 + tid) * 8 + h]; }
    if (tid < 16) flg[tid] = 0u;
    const int qs = qblk * 256 + 32 * wave + l31;
    const size_t qtok = (size_t)b * SEQ + qs;
    bf16x8 qf[8]; float qn2 = 0.f;
#pragma unroll
    for (int ks = 0; ks < 8; ++ks) { qf[ks] = *(const bf16x8*)(QB + qtok * 1024 + h * 128 + 16 * ks + 8 * half);
#pragma unroll
        for (int e = 0; e < 8; ++e) { const float v = bf2f((unsigned)(unsigned short)qf[ks][e]); qn2 += v * v; } }
    qn2 += __shfl_xor(qn2, 32);
    __syncthreads();
    if (wave == 0) { float m = fmaxf(red[lane], red[lane + 64]);
#pragma unroll
        for (int o = 1; o < 64; o <<= 1) m = fmaxf(m, __shfl_xor(m, o));
        if (lane == 0) kmx[0] = m; }
    if (tid < ntiles) ce[tid] = (LC[((size_t)b * SEQ + 64 * tid + 63) * 8 + h] + cpre[tid]) * LOG2E;
    const float cq = (LC[qtok * 8 + h] + cpre[qs >> 6]) * LOG2E;
    v4u kr[2], vr[2]; float ckr = 0.f;
    const int krow_[2] = {tid >> 4, (tid + 512) >> 4}, kc16 = tid & 15;
    const int vrow_[2] = {tid >> 3, (tid + 512) >> 3}, vc16 = tid & 7;
#define FOX_LOAD(t) do { const size_t k0 = (size_t)b * SEQ + 64 * (t); \
        _Pragma("unroll") for (int i = 0; i < 2; ++i) { kr[i] = *(const v4u*)(KB + (k0 + krow_[i]) * 1024 + h * 128 + 8 * kc16); vr[i] = *(const v4u*)(VT + (size_t)(h * 128 + vrow_[i]) * M + k0 + 8 * vc16); } \
        if (tid < 64) ckr = (LC[(k0 + tid) * 8 + h] + cpre[(t)]) * LOG2E; } while (0)
#define FOX_STORE(buf) do { LAS unsigned char* Kl = lds + (buf) * BUFB; LAS unsigned char* Vl = Kl + KBYTES; \
        _Pragma("unroll") for (int i = 0; i < 2; ++i) { *(LAS v4u*)(Kl + krow_[i] * KSTR + 16 * kc16) = kr[i]; *(LAS v4u*)(Vl + vrow_[i] * VSTR + 16 * vc16) = vr[i]; } \
        if (tid < 64) ck[(buf) * 64 + tid] = ckr; } while (0)
    FOX_LOAD(ntiles - 1); FOX_STORE(0);
    __syncthreads();
    const float qk_ub = sqrtf(qn2) * sqrtf(kmx[0]) * 1.02f;
    f32x16 o[4];
#pragma unroll
    for (int rb = 0; rb < 4; ++rb)
#pragma unroll
        for (int i = 0; i < 16; ++i) o[rb][i] = 0.f;
    float mrun = -INFINITY, lrun = 0.f;
    const int qmin = qblk * 256 + 32 * wave;
    const int kperm = prow(l31);
    for (int st = 0; st < ntiles; ++st) {
        const int t = ntiles - 1 - st, buf = st & 1;
#if FOX_SKIP
        if (st > 0) { const LAS unsigned* f = flg + ((st - 1) & 1) * 8; const unsigned all = f[0] & f[1] & f[2] & f[3] & f[4] & f[5] & f[6] & f[7]; if (all) break; }
#endif
        if (t > 0) FOX_LOAD(t - 1);
        const int kpos0 = 64 * t;
        if (kpos0 <= qmin + 31) {
            const bool full = (kpos0 + 63 <= qmin);
            LAS unsigned char* Kl = lds + buf * BUFB; LAS unsigned char* Vl = Kl + KBYTES;
            f32x16 s[2];
#pragma unroll
            for (int blk = 0; blk < 2; ++blk) {
#pragma unroll
                for (int i = 0; i < 16; ++i) s[blk][i] = 0.f;
#pragma unroll
                for (int ks = 0; ks < 8; ++ks) { const bf16x8 a = *(const LAS bf16x8*)(Kl + (32 * blk + kperm) * KSTR + 32 * ks + 16 * half); s[blk] = MFMA32(a, qf[ks], s[blk]); }
            }
            float mx = -INFINITY;
#pragma unroll
            for (int blk = 0; blk < 2; ++blk)
#pragma unroll
                for (int g = 0; g < 2; ++g) { const int key0 = 32 * blk + 16 * g + 8 * half; const f32x4 c0 = *(const LAS f32x4*)(ck + buf * 64 + key0), c1 = *(const LAS f32x4*)(ck + buf * 64 + key0 + 4);
#pragma unroll
                    for (int e = 0; e < 8; ++e) { const int i = 8 * g + e; float sc = s[blk][i] + (cq - (e < 4 ? c0[e & 3] : c1[e & 3]));
                        if (!full && (kpos0 + key0 + e > qs)) sc = -INFINITY;
                        s[blk][i] = sc; mx = fmaxf(mx, sc); } }
            mx = fmaxf(mx, __shfl_xor(mx, 32));
            const float mnew = fmaxf(mrun, mx), alpha = __builtin_amdgcn_exp2f(mrun - mnew); mrun = mnew;
            float ps = 0.f;
#pragma unroll
            for (int blk = 0; blk < 2; ++blk)
#pragma unroll
                for (int i = 0; i < 16; ++i) { const float p = __builtin_amdgcn_exp2f(s[blk][i] - mnew); s[blk][i] = p; ps += p; }
            lrun = lrun * alpha + ps;
#pragma unroll
            for (int rb = 0; rb < 4; ++rb)
#pragma unroll
                for (int i = 0; i < 16; ++i) o[rb][i] *= alpha;
            bf16x8 pf[4];
#pragma unroll
            for (int k4 = 0; k4 < 4; ++k4) pf[k4] = pack8(s[k4 >> 1], k4 & 1);
#pragma unroll
            for (int rb = 0; rb < 4; ++rb)
#pragma unroll
                for (int k4 = 0; k4 < 4; ++k4) { const bf16x8 a = *(const LAS bf16x8*)(Vl + (32 * rb + l31) * VSTR + 32 * k4 + 16 * half); o[rb] = MFMA32(a, pf[k4], o[rb]); }
        }
#if FOX_SKIP
        {
            bool ok = false;
            if (t > 0) ok = (qk_ub + (cq - ce[t - 1]) < mrun - 150.0f);
            const bool wave_ok = __builtin_amdgcn_ballot_w64(ok) == ~0ull;
            if (lane == 0) flg[(st & 1) * 8 + wave] = wave_ok ? 1u : 0u;
        }
#endif
        if (t > 0) FOX_STORE(buf ^ 1);
        __syncthreads();
    }
    const float ltot = lrun + __shfl_xor(lrun, 32), inv = 1.0f / ltot;
    bf16* orow = QB + qtok * 1024 + h * 128;
#pragma unroll
    for (int rb = 0; rb < 4; ++rb)
#pragma unroll
        for (int g = 0; g < 4; ++g) { v2u w; w.x = pk2(o[rb][4 * g] * inv, o[rb][4 * g + 1] * inv); w.y = pk2(o[rb][4 * g + 2] * inv, o[rb][4 * g + 3] * inv);
            *(v2u*)(orow + 32 * rb + 8 * g + 4 * half) = w; }
    __syncthreads();
#undef FOX_LOAD
#undef FOX_STORE
}
__device__ __forceinline__ void kmax_block(LAS unsigned char* lds, int w, const bf16* KB, float* KMAXP, int wave) {
    const int lane = fresh_lane(); LAS float* red = (LAS float*)lds;
    float mx = 0.f;
    for (int i = 0; i < 8; ++i) { const size_t tok = (size_t)w * 64 + wave * 8 + i; const v4u a = *(const v4u*)(KB + tok * 1024 + 16 * lane), c = *(const v4u*)(KB + tok * 1024 + 16 * lane + 8); float s = 0.f;
#pragma unroll
        for (int e = 0; e < 4; ++e) { const float x0 = bf2f(a[e] & 0xffffu), x1 = bf2f(a[e] >> 16), y0 = bf2f(c[e] & 0xffffu), y1 = bf2f(c[e] >> 16); s += (x0 * x0 + x1 * x1) + (y0 * y0 + y1 * y1); }
        s += __shfl_xor(s, 1); s += __shfl_xor(s, 2); s += __shfl_xor(s, 4); mx = fmaxf(mx, s); }
    if ((lane & 7) == 0) red[wave * 8 + (lane >> 3)] = mx;
    __syncthreads();
    if (wave == 0 && lane < 8) { float m = red[lane];
#pragma unroll
        for (int j = 1; j < 8; ++j) m = fmaxf(m, red[j * 8 + lane]);
        KMAXP[w * 8 + lane] = m; }
    __syncthreads();
}
}

namespace hg {
constexpr int RS = 272;
constexpr int IMG_BYTES = 2 * 64 * RS, QH_OFF = 0, KH_OFF = 64 * RS, ST_OFF = 2 * IMG_BYTES, ST_BYTES = 32 * RS, OP_OFF = ST_OFF + 2 * ST_BYTES, OP_BYTES = 4096, OI_OFF = OP_OFF + 2 * OP_BYTES, OI_BYTES = 8192,
              END_OFF = OI_OFF + 2 * OI_BYTES;
static_assert(END_OFF <= RING_BYTES, "hgrn lds");
__device__ __forceinline__ void prepass_item(LAS unsigned char* lds, int item, bf16* QA, bf16* LF, bf16* KHT, float* D1, float* D2, int wave) {
    const int lane = fresh_lane(), tid = wave * 64 + lane;
    const int b = item >> 10, h = (item >> 7) & 7, n = item & 127;
    const int c = tid & 127, tg = tid >> 7;
    LAS float* GTOT = (LAS float*)lds;
    const size_t t0 = (size_t)b * SEQ + 64 * n + 16 * tg;
    float lf[16], bl[16], qv[16]; float run = 0.f;
#pragma unroll
    for (int k = 0; k < 16; ++k) { lf[k] = bf2f(LF[(t0 + k) * 1024 + h * 128 + c]); qv[k] = bf2f(QA[(t0 + k) * 1024 + h * 128 + c]); }
#pragma unroll
    for (int k = 0; k < 16; ++k) { run += lf[k]; bl[k] = run; }
    GTOT[tg * 128 + c] = run;
    __syncthreads();
    const float g0 = GTOT[c], g1 = GTOT[128 + c], g2 = GTOT[256 + c], g3 = GTOT[384 + c];
    const float off = (tg > 0 ? g0 : 0.f) + (tg > 1 ? g1 : 0.f) + (tg > 2 ? g2 : 0.f);
    const float b31 = g0 + g1, b63 = b31 + g2 + g3;
    unsigned kt[8];
#pragma unroll
    for (int k = 0; k < 16; k += 2) { float qh[2], kk[2];
#pragma unroll
        for (int e = 0; e < 2; ++e) { const float bp = off + bl[k + e] - b31; qh[e] = qv[k + e] * __expf(bp); kk[e] = (1.0f - __expf(lf[k + e])) * __expf(-bp); }
        const unsigned qp = pk2(qh[0], qh[1]), kp2 = pk2(kk[0], kk[1]);
        const size_t a = (t0 + k) * 1024 + h * 128 + c;
        QA[a] = (bf16)(qp & 0xffffu); QA[a + 1024] = (bf16)(qp >> 16); LF[a] = (bf16)(kp2 & 0xffffu); LF[a + 1024] = (bf16)(kp2 >> 16);
        kt[k >> 1] = kp2; }
    v4u* kp = (v4u*)(KHT + (size_t)(h * 128 + c) * M + t0);
    kp[0] = (v4u){kt[0], kt[1], kt[2], kt[3]}; kp[1] = (v4u){kt[4], kt[5], kt[6], kt[7]};
    if (tg == 0) { const size_t di = (size_t)(b * 128 + n) * 1024 + h * 128 + c; D1[di] = __expf(b31); D2[di] = __expf(b63 - b31); }
    __syncthreads();
}
__device__ __forceinline__ void unit(LAS unsigned char* lds, int u, const bf16* QH, const bf16* KH, const bf16* KHT, const float* D1, const float* D2, const bf16* IT, bf16* GA, const float* hgg, float* SSQ, int wave) {
    const int lane = fresh_lane(), tid = wave * 64 + lane;
    const int b = u >> 5, h = (u >> 2) & 7, vs = u & 3;
    const int half = lane >> 5, l31 = lane & 31;
    const size_t tok0 = (size_t)b * SEQ;
    constexpr int NCH = SEQ / 64;
    for (int i = tid; i < ST_BYTES / 4; i += NT) ((LAS unsigned*)(lds + ST_OFF))[i] = 0u;
    f32x16 S, oa;
#pragma unroll
    for (int i = 0; i < 16; ++i) { S[i] = 0.f; oa[i] = 0.f; }
    v4u sr[2][2]; bf16x8 itn[4], khn[4]; float d1n = 0.f, d2n = 0.f, d1nn = 0.f, d2nn = 0.f; v2u gan[4], gap[4];
    const int srow[2] = {tid >> 4, (tid + 512) >> 4}, sc16 = tid & 15;
    const bf16* itrow = IT + (size_t)(h * 128 + 32 * vs + l31) * M + tok0 + 8 * half;
    const int cc = 32 * (wave & 3) + l31;
    const bf16* khtrow = KHT + (size_t)(h * 128 + cc) * M + tok0 + 8 * half;
    const int tbw = wave & 1;
    f32x4 gnv[4];
#pragma unroll
    for (int g = 0; g < 4; ++g) { gnv[g] = *(const f32x4*)(hgg + h * 128 + 32 * vs + 8 * g + 4 * half); gap[g] = (v2u){0u, 0u}; gan[g] = (v2u){0u, 0u}; }
#define HG_STAGE_LOAD(n) do { _Pragma("unroll") for (int i = 0; i < 2; ++i) { const size_t a = (tok0 + 64 * (n) + srow[i]) * 1024 + h * 128 + 8 * sc16; \
        sr[0][i] = *(const v4u*)(QH + a); sr[1][i] = *(const v4u*)(KH + a); } } while (0)
#define HG_STAGE_STORE(buf) do { LAS unsigned char* I_ = lds + (buf) * IMG_BYTES; _Pragma("unroll") for (int i = 0; i < 2; ++i) { \
        *(LAS v4u*)(I_ + QH_OFF + srow[i] * RS + 16 * sc16) = sr[0][i]; *(LAS v4u*)(I_ + KH_OFF + srow[i] * RS + 16 * sc16) = sr[1][i]; } } while (0)
#define HG_D_LOAD(n, d1v, d2v) do { if (wave < 4 && (n) < NCH) { const size_t di = (size_t)(b * 128 + (n)) * 1024 + h * 128 + cc; d1v = D1[di]; d2v = D2[di]; } } while (0)
#define HG_ROLE_LOAD(n) do { if (wave < 7) { _Pragma("unroll") for (int ks = 0; ks < 4; ++ks) itn[ks] = *(const bf16x8*)(itrow + 64 * (n) + 16 * ks); } \
        if (wave < 4) { _Pragma("unroll") for (int ks = 0; ks < 4; ++ks) khn[ks] = *(const bf16x8*)(khtrow + 64 * (n) + 16 * ks); } \
        else if (wave < 6) { const bf16* gp_ = GA + (tok0 + 64 * (n) + 32 * tbw + l31) * 1024 + h * 128 + 32 * vs; _Pragma("unroll") for (int g = 0; g < 4; ++g) gan[g] = *(const v2u*)(gp_ + 8 * g + 4 * half); } } while (0)
#define HG_FINAL(nn) do { LAS float* OIp = (LAS float*)(lds + OI_OFF + ((nn) & 1) * OI_BYTES) + tbw * 1024; LAS float* OPp = (LAS float*)(lds + OP_OFF + ((nn) & 1) * OP_BYTES); \
        const size_t tok = tok0 + 64 * (nn) + 32 * tbw + l31; float ssq = 0.f; bf16* gp = GA + tok * 1024 + h * 128 + 32 * vs; \
        _Pragma("unroll") for (int g = 0; g < 4; ++g) { float a_[4]; \
            _Pragma("unroll") for (int e = 0; e < 4; ++e) { const int i = 4 * g + e; float v_ = oa[i] + OIp[i * 64 + lane]; if (tbw) v_ += OPp[i * 64 + lane]; a_[e] = v_; } \
            ssq += (a_[0] * a_[0] + a_[1] * a_[1]) + (a_[2] * a_[2] + a_[3] * a_[3]); const v2u gw = gap[g]; const f32x4 gn = gnv[g]; \
            v2u w; w.x = pk2(a_[0] * gn[0] * bf2f(gw.x & 0xffffu), a_[1] * gn[1] * bf2f(gw.x >> 16)); w.y = pk2(a_[2] * gn[2] * bf2f(gw.y & 0xffffu), a_[3] * gn[3] * bf2f(gw.y >> 16)); \
            *(v2u*)(gp + 8 * g + 4 * half) = w; } \
        ssq += __shfl_xor(ssq, 32); if (half == 0) SSQ[tok * 32 + h * 4 + vs] = ssq; } while (0)
    HG_STAGE_LOAD(0); HG_ROLE_LOAD(0); HG_D_LOAD(0, d1n, d2n); HG_D_LOAD(1, d1nn, d2nn); HG_STAGE_STORE(0);
    __syncthreads();
    const int kp = prow(l31);
    for (int n = 0; n < NCH; ++n) {
        bf16x8 itc[4], khc[4]; v2u gac[4]; const float d1 = d1n, d2 = d2n;
#pragma unroll
        for (int ks = 0; ks < 4; ++ks) { itc[ks] = itn[ks]; khc[ks] = khn[ks]; gac[ks] = gan[ks]; }
        d1n = d1nn; d2n = d2nn;
        if (n + 1 < NCH) { HG_STAGE_LOAD(n + 1); HG_ROLE_LOAD(n + 1); }
        HG_D_LOAD(n + 2, d1nn, d2nn);
        LAS unsigned char* IM = lds + (n & 1) * IMG_BYTES;
        LAS unsigned char* STc = lds + ST_OFF + (n & 1) * ST_BYTES; LAS unsigned char* STn = lds + ST_OFF + ((n + 1) & 1) * ST_BYTES;
        if (wave < 4) {
            f32x16 acc;
#pragma unroll
            for (int i = 0; i < 16; ++i) acc[i] = S[i] * d1;
#pragma unroll
            for (int ks = 0; ks < 4; ++ks) acc = MFMA32(itc[ks], khc[ks], acc);
#pragma unroll
            for (int i = 0; i < 16; i += 2) { S[i] = acc[i] * d2; S[i + 1] = acc[i + 1] * d2; const unsigned w = pk2(S[i] * d1n, S[i + 1] * d1n);
                *(LAS unsigned short*)(STn + crow(i, half) * RS + 2 * cc) = (unsigned short)(w & 0xffffu); *(LAS unsigned short*)(STn + crow(i + 1, half) * RS + 2 * cc) = (unsigned short)(w >> 16); }
        } else if (wave < 6) {
            if (n > 0) HG_FINAL(n - 1);
            const int t = 32 * tbw + l31;
            f32x16 am;
#pragma unroll
            for (int i = 0; i < 16; ++i) am[i] = 0.f;
#pragma unroll
            for (int ks = 0; ks < 8; ++ks) { const bf16x8 a = *(const LAS bf16x8*)(IM + KH_OFF + (32 * tbw + kp) * RS + 32 * ks + 16 * half); const bf16x8 q = *(const LAS bf16x8*)(IM + QH_OFF + t * RS + 32 * ks + 16 * half); am = MFMA32(a, q, am); }
#pragma unroll
            for (int i = 0; i < 16; ++i) { const int s = 16 * (i >> 3) + 8 * half + (i & 7); if (s > l31) am[i] = 0.f; }
            const bf16x8 p0 = pack8(am, 0), p1 = pack8(am, 1);
#pragma unroll
            for (int i = 0; i < 16; ++i) oa[i] = 0.f;
            if (tbw == 0) { oa = MFMA32(itc[0], p0, oa); oa = MFMA32(itc[1], p1, oa); } else { oa = MFMA32(itc[2], p0, oa); oa = MFMA32(itc[3], p1, oa); }
#pragma unroll
            for (int g = 0; g < 4; ++g) gap[g] = gac[g];
        } else if (wave == 6) {
            const int t = 32 + l31;
            f32x16 am, o;
#pragma unroll
            for (int i = 0; i < 16; ++i) { am[i] = 0.f; o[i] = 0.f; }
#pragma unroll
            for (int ks = 0; ks < 8; ++ks) { const bf16x8 a = *(const LAS bf16x8*)(IM + KH_OFF + kp * RS + 32 * ks + 16 * half); const bf16x8 q = *(const LAS bf16x8*)(IM + QH_OFF + t * RS + 32 * ks + 16 * half); am = MFMA32(a, q, am); }
            const bf16x8 p0 = pack8(am, 0), p1 = pack8(am, 1);
            o = MFMA32(itc[0], p0, o); o = MFMA32(itc[1], p1, o);
            LAS float* OPc = (LAS float*)(lds + OP_OFF + (n & 1) * OP_BYTES);
#pragma unroll
            for (int i = 0; i < 16; ++i) OPc[i * 64 + lane] = o[i];
        } else {
            LAS float* OIc = (LAS float*)(lds + OI_OFF + (n & 1) * OI_BYTES);
            f32x16 o0, o1;
#pragma unroll
            for (int i = 0; i < 16; ++i) { o0[i] = 0.f; o1[i] = 0.f; }
#pragma unroll
            for (int ks = 0; ks < 8; ++ks) { const bf16x8 a = *(const LAS bf16x8*)(STc + l31 * RS + 32 * ks + 16 * half);
                const bf16x8 q0 = *(const LAS bf16x8*)(IM + QH_OFF + l31 * RS + 32 * ks + 16 * half), q1 = *(const LAS bf16x8*)(IM + QH_OFF + (32 + l31) * RS + 32 * ks + 16 * half);
                o0 = MFMA32(a, q0, o0); o1 = MFMA32(a, q1, o1); }
#pragma unroll
            for (int i = 0; i < 16; ++i) { OIc[i * 64 + lane] = o0[i]; OIc[1024 + i * 64 + lane] = o1[i]; }
        }
        if (n + 1 < NCH) HG_STAGE_STORE((n + 1) & 1);
        __syncthreads();
    }
    if (wave == 4 || wave == 5) HG_FINAL(NCH - 1);
    __syncthreads();
#undef HG_STAGE_LOAD
#undef HG_STAGE_STORE
#undef HG_ROLE_LOAD
#undef HG_D_LOAD
#undef HG_FINAL
}
}

#define XB_TMO      128
#define XB_XCNT(j)  (256  + 64 * (j))
#define XB_XSUB(j)  (1280 + 64 * (j))
#define XB_XGEN(j)  (2304 + 64 * (j))
#define XB_TOP      3328
#define XB_TOPGEN   3392
#define XCD_BAR_WORDS 3456
#define XB_SPIN_CAP (1u << 18)

__device__ __forceinline__ unsigned xb_ld(unsigned* p)              { return __hip_atomic_load(p, __ATOMIC_RELAXED, __HIP_MEMORY_SCOPE_AGENT); }
__device__ __forceinline__ unsigned xb_add(unsigned* p, unsigned v) { return __hip_atomic_fetch_add(p, v, __ATOMIC_RELAXED, __HIP_MEMORY_SCOPE_AGENT); }
__device__ __forceinline__ unsigned xb_xcc_id() { return (unsigned)__builtin_amdgcn_s_getreg((3 << 11) | 20) & 0xFu; }
#define XB_SPIN(cond, bar) do { unsigned _sp = 0; while (cond) { __builtin_amdgcn_s_sleep(1); \
    if ((++_sp & 255u) == 0u) { if (xb_ld(&(bar)[XB_TMO])) break; if (_sp > XB_SPIN_CAP) { atomicAdd(&(bar)[XB_TMO], 1u); break; } } } } while (0)

struct XcdBarrier {
    unsigned* bar; unsigned x;
    volatile LAS unsigned* st;
};

__device__ __forceinline__ XcdBarrier xcd_barrier_post(unsigned* bar, volatile LAS unsigned* st, int tid) {
    XcdBarrier b; b.bar = bar; b.x = xb_xcc_id(); b.st = st;
    if (tid == 0) (void)xb_add(&bar[XB_XCNT(b.x)], 1u);
    return b;
}
__device__ __forceinline__ void xcd_barrier_complete(unsigned* bar, unsigned x, unsigned& nloc, unsigned& nx) {
    const unsigned G = gridDim.x * gridDim.y * gridDim.z;
    unsigned sum, cnt, mine, sp = 0u;
    for (;;) {
        sum = 0u; cnt = 0u; mine = 0u;
#pragma unroll
        for (unsigned j = 0; j < 16; ++j) { const unsigned c = xb_ld(&bar[XB_XCNT(j)]); sum += c; cnt += (c > 0u) ? 1u : 0u; mine = (j == x) ? c : mine; }
        if (sum == G) break;
        __builtin_amdgcn_s_sleep(1);
        if ((++sp & 255u) == 0u) { if (xb_ld(&bar[XB_TMO])) break; if (sp > XB_SPIN_CAP) { atomicAdd(&bar[XB_TMO], 1u); break; } }
    }
    nloc = mine > 0u ? mine : 1u; nx = cnt > 0u ? cnt : 1u;
}

__device__ __forceinline__ void xcd_barrier(const XcdBarrier& b, int tid) {
    asm volatile("s_waitcnt vmcnt(0)" ::: "memory");
    __syncthreads();
    if (tid == 0) {
        unsigned* bar = b.bar;
        __builtin_amdgcn_s_waitcnt(0);
        unsigned nloc = b.st[0], nx = b.st[1];
        if (nloc == 0u) { xcd_barrier_complete(bar, b.x, nloc, nx); b.st[0] = nloc; b.st[1] = nx; }
        const unsigned old = xb_add(&bar[XB_XSUB(b.x)], 1u);
        const unsigned gen = old / nloc;
        if (old + 1u == (gen + 1u) * nloc) {
            __builtin_amdgcn_fence(__ATOMIC_RELEASE, "agent");
            asm volatile("s_waitcnt vmcnt(0)" ::: "memory");
            const unsigned og = xb_add(&bar[XB_TOP], 1u);
            const unsigned tg = og / nx;
            if (og + 1u == (tg + 1u) * nx) xb_add(&bar[XB_TOPGEN], 1u);
            else XB_SPIN(xb_ld(&bar[XB_TOPGEN]) == tg, bar);
            __builtin_amdgcn_fence(__ATOMIC_ACQUIRE, "agent");
            xb_add(&bar[XB_XGEN(b.x)], 1u);
            asm volatile("s_waitcnt vmcnt(0)" ::: "memory");
        } else {
            XB_SPIN(xb_ld(&bar[XB_XGEN(b.x)]) == gen, bar);
            __builtin_amdgcn_fence(__ATOMIC_ACQUIRE, "agent");
            asm volatile("s_waitcnt vmcnt(0)" ::: "memory");
        }
    }
    __syncthreads();
}


__device__ __forceinline__ void wg_arrive(unsigned* ctr, int tid) {
    asm volatile("s_waitcnt vmcnt(0)" ::: "memory"); __syncthreads();
    if (tid == 0) { __builtin_amdgcn_fence(__ATOMIC_RELEASE, "agent"); asm volatile("s_waitcnt vmcnt(0)" ::: "memory"); (void)__hip_atomic_fetch_add(ctr, 1u, __ATOMIC_RELAXED, __HIP_MEMORY_SCOPE_AGENT); }
}
__device__ __forceinline__ void wg_wait(unsigned* ctr, unsigned want, int tid) {
    if (tid == 0) { unsigned sp = 0; while (__hip_atomic_load(ctr, __ATOMIC_RELAXED, __HIP_MEMORY_SCOPE_AGENT) < want) { __builtin_amdgcn_s_sleep(4); if (++sp > (1u << 22)) break; }
        __builtin_amdgcn_fence(__ATOMIC_ACQUIRE, "agent"); asm volatile("s_waitcnt vmcnt(0)" ::: "memory"); }
    __syncthreads();
}
typedef const __attribute__((address_space(4))) Ptrs* KPtr;
#define WSP() ({ unsigned char* w_ = KP->ws; asm volatile("" : "+s"(w_)); w_; })
#define GBP() ({ unsigned char* g_ = g_buf; asm volatile("" : "+s"(g_)); g_; })
#define PH_BEGIN unsigned char* ws = WSP(); unsigned char* gb = GBP(); int wave = wave0; asm volatile("" : "+s"(wave)); const int G = gridDim.x, bx = blockIdx.x; (void)ws; (void)gb; (void)G; (void)bx;
#define IDS const int lane = fresh_lane(); const int tid = wave * 64 + lane; (void)tid; (void)lane
__global__ void __launch_bounds__(NT, 2) fwd(Ptrs P_unused) {
    KPtr KP = (KPtr)__builtin_amdgcn_kernarg_segment_ptr();
#define P (*KP)
    extern __shared__ __attribute__((aligned(16))) unsigned char lds_raw[];
    LAS unsigned char* lds = (LAS unsigned char*)lds_raw;
    const int wave0 = __builtin_amdgcn_readfirstlane((int)threadIdx.x >> 6);
    const int lo = P.ph_lo, hi = P.ph_hi;
#define IN(k) (lo <= (k) && (k) < hi)
#define SEAM(k) do { if (IN(k) && IN((k) + 1)) { if ((k) == 0) cg::this_grid().sync(); else { PH_BEGIN; IDS; XcdBarrier bar; bar.bar = (unsigned*)(ws + WS_CTL) + CW_BAR; bar.x = xb_xcc_id(); bar.st = (volatile LAS unsigned*)(lds + MISC_OFF + 32); xcd_barrier(bar, tid); } } } while (0)
    if (hi - lo > 1) { PH_BEGIN; IDS; volatile LAS unsigned* st = (volatile LAS unsigned*)(lds + MISC_OFF + 32); if (tid < 2) st[tid] = 0u; __syncthreads(); (void)xcd_barrier_post((unsigned*)(ws + WS_CTL) + CW_BAR, st, tid); }

    if (IN(0)) { p0_prologue(KP, lds, wave0); }
    SEAM(0);
    if (IN(1)) { PH_BEGIN;
        { pg8::Gemm g{(const bf16*)(ws + WS_XN), (const bf16*)(ws + WS_W1A), M, 2 * DFF, D}; pg8::StaticOrder S; S.init(M, 2 * DFF, G, bx); pg8::EpiSwiglu E{(bf16*)(ws + WS_HID), DFF};
          pg8::gemm_phase<pg8::EpiSwiglu, pg8::StaticOrder, true, true>(lds, g, S, E, wave); }
        { pg8::Gemm g{(const bf16*)(ws + WS_MEMN), (const bf16*)(ws + WS_WMKV), MROWS, 2 * D, D}; pg8::ListOrder S{MROWS / 256, G >= 144 ? 128 : 0, 16, bx}; pg8::EpiMemKV E{(bf16*)(ws + WS_KM), (bf16*)(ws + WS_VTM)};
          pg8::gemm_phase<pg8::EpiMemKV, pg8::ListOrder, false, true>(lds, g, S, E, wave); }
    }
    SEAM(1);
    if (IN(2)) { PH_BEGIN; pg8::Gemm g{(const bf16*)(ws + WS_HID), (const bf16*)(ws + WS_W1D), M, D, DFF}; pg8::StaticOrder S; S.init(M, D, G, bx); pg8::EpiF32 E{(float*)(gb + GB_Z), D};
        pg8::gemm_phase<pg8::EpiF32, pg8::StaticOrder, true, true>(lds, g, S, E, wave); }
    SEAM(2);
    if (IN(3)) { PH_BEGIN; rowpass<true, true>(P.x, (const float*)(gb + GB_Z), P.f1pg, 0.5f, P.out, P.mixg, (bf16*)(ws + WS_XN), (const float*)(ws + WS_WF), P.fbias, (float*)(ws + WS_LC), (float*)(ws + WS_BT), lds, wave); }
    SEAM(3);
    if (IN(4)) { PH_BEGIN;
        { pg8::Gemm g{(const bf16*)(ws + WS_XN), (const bf16*)(ws + WS_WIN), M, 3072, D}; pg8::StaticOrder S; S.init(M, 3072, G, bx);
          pg8::EpiInproj E{(bf16*)(ws + WS_QA), (bf16*)(ws + WS_LF), (bf16*)(gb + GB_GA), (bf16*)(gb + GB_QB), (bf16*)(gb + GB_KB), (bf16*)(gb + GB_GT), P.lbl, P.bgate, LOG2E * 0.08838834764831845f, 0};
          pg8::gemm_phase<pg8::EpiInproj, pg8::StaticOrder, true, true>(lds, g, S, E, wave); }
        { pg8::Gemm g{(const bf16*)(ws + WS_WIN) + (size_t)7168 * D, (const bf16*)(ws + WS_XN), 1024, M, D}; pg8::StaticOrder S; S.init(1024, M, G, bx); pg8::EpiBf16P E{(bf16*)(ws + WS_IT), M, 1.0f};
          pg8::gemm_phase<pg8::EpiBf16P, pg8::StaticOrder, true, true>(lds, g, S, E, wave); }
    }
    SEAM(4);
    if (IN(5)) { PH_BEGIN;
        for (int it = bx; it < 2048; it += G) hg::prepass_item(lds, it, (bf16*)(ws + WS_QA), (bf16*)(ws + WS_LF), (bf16*)(gb + GB_KHT), (float*)(ws + WS_D1), (float*)(ws + WS_D2), wave);
    }
    SEAM(5);
    if (IN(6)) { PH_BEGIN;
        unsigned* ctl = (unsigned*)(ws + WS_CTL);
        constexpr int NH_ = 64;
        const int GW = G - NH_;
        if (bx < NH_) { hg::unit(lds, bx, (const bf16*)(ws + WS_QA), (const bf16*)(ws + WS_LF), (const bf16*)(gb + GB_KHT), (const float*)(ws + WS_D1), (const float*)(ws + WS_D2), (const bf16*)(ws + WS_IT), (bf16*)(gb + GB_GA), P.hgg, (float*)(ws + WS_SSQ), wave); }
        if (bx >= NH_) { const int c = bx - NH_;
            { pg8::Gemm g{(const bf16*)(ws + WS_XN), (const bf16*)(ws + WS_WIN) + (size_t)3072 * D, M, 4096, D}; pg8::StaticOrder S; S.init(M, 4096, GW, c);
              pg8::EpiInproj E{(bf16*)(ws + WS_QA), (bf16*)(ws + WS_LF), (bf16*)(gb + GB_GA), (bf16*)(gb + GB_QB), (bf16*)(gb + GB_KB), (bf16*)(gb + GB_GT), P.lbl, P.bgate, LOG2E * 0.08838834764831845f, 12};
              pg8::gemm_phase<pg8::EpiInproj, pg8::StaticOrder, true, true>(lds, g, S, E, wave); }
            { pg8::Gemm g{(const bf16*)(ws + WS_WIN) + (size_t)8192 * D, (const bf16*)(ws + WS_XN), 1024, M, D}; pg8::StaticOrder S; S.init(1024, M, GW, c); pg8::EpiBf16P E{(bf16*)(ws + WS_VT), M, 1.0f};
              pg8::gemm_phase<pg8::EpiBf16P, pg8::StaticOrder, true, true>(lds, g, S, E, wave); }
            { IDS; wg_arrive(ctl + 64, tid); wg_wait(ctl + 64, (unsigned)GW, tid); }
            for (int w = c; w < M / 64; w += GW) fox::kmax_block(lds, w, (const bf16*)(gb + GB_KB), (float*)(ws + WS_KMAXP), wave);
            { IDS; wg_arrive(ctl + 128, tid); }
        }
        LAS int* sh = (LAS int*)(lds + MISC_OFF); IDS;
        wg_wait(ctl + 128, (unsigned)GW, tid);
        for (;;) {
            __syncthreads();
            if (tid == 0) sh[0] = (int)atomicAdd(ctl, 1u);
            __syncthreads();
            const int u = sh[0];
            if (u >= 512) break;
            fox::unit(lds, u, (bf16*)(gb + GB_QB), (const bf16*)(gb + GB_KB), (const bf16*)(ws + WS_VT), (const float*)(ws + WS_LC), (const float*)(ws + WS_BT), (const float*)(ws + WS_KMAXP), wave);
        }
    }
    SEAM(6);
    if (IN(7)) { PH_BEGIN;
        pg8::StaticOrder S; S.init(M, D, G, bx); float* RSTD = (float*)(ws + WS_RSTD);
        { IDS; const float* SSQ = (const float*)(ws + WS_SSQ); pg8::Unit u; for (int i = 0; S.next(i, u); ++i) { const int r = tid >> 1, sub = tid & 1; const float* sp = SSQ + (size_t)(u.pm * 256 + r) * 32 + 16 * sub; float s = 0.f;
#pragma unroll
                for (int j = 0; j < 16; ++j) s += sp[j];
                s += __shfl_xor(s, 1);
                if (sub == 0) RSTD[(size_t)u.pn * M + u.pm * 256 + r] = 1.0f / sqrtf(s * (1.0f / D) + EPS); } }
        __threadfence(); __syncthreads();
        { pg8::Gemm g{(const bf16*)(gb + GB_GA), (const bf16*)(ws + WS_WBA), M, D, D}; pg8::EpiBranchA E{(bf16*)(gb + GB_GT), RSTD}; pg8::gemm_phase<pg8::EpiBranchA, pg8::StaticOrder, true, true>(lds, g, S, E, wave); }
        { pg8::Gemm g{(const bf16*)(gb + GB_QB), (const bf16*)(ws + WS_WBB), M, D, D}; pg8::EpiBranchB E{(const bf16*)(gb + GB_GT), (bf16*)(ws + WS_Y)}; pg8::gemm_phase<pg8::EpiBranchB, pg8::StaticOrder, true, true>(lds, g, S, E, wave); }
    }
    SEAM(7);
    if (IN(8)) { PH_BEGIN; pg8::Gemm g{(const bf16*)(ws + WS_Y), (const bf16*)(ws + WS_WOUT), M, D, D}; pg8::StaticOrder S; S.init(M, D, G, bx); pg8::EpiF32 E{(float*)(gb + GB_Z), D}; pg8::gemm_phase<pg8::EpiF32, pg8::StaticOrder, true, true>(lds, g, S, E, wave); }
    SEAM(8);
    if (IN(9)) { PH_BEGIN; rowpass<true, false>(P.out, (const float*)(gb + GB_Z), P.mixpg, 1.0f, P.out, P.mempg, (bf16*)(ws + WS_XN), nullptr, nullptr, nullptr, nullptr, lds, wave); }
    SEAM(9);
    if (IN(10)) { PH_BEGIN; pg8::Gemm g{(const bf16*)(ws + WS_XN), (const bf16*)(ws + WS_WMQ), M, D, D}; pg8::StaticOrder S; S.init(M, D, G, bx); pg8::EpiHeadSplit E{(bf16*)(ws + WS_QMH), M, LOG2E * 0.0625f};
        pg8::gemm_phase<pg8::EpiHeadSplit, pg8::StaticOrder, true, true>(lds, g, S, E, wave); }
    SEAM(10);
    if (IN(11)) { PH_BEGIN;
        pg8::CrossOrder S; S.so.init(M, D, G, bx); S.Mrows = M; S.pm_per_batch = SEQ / 256;
        { pg8::Gemm g{(const bf16*)(ws + WS_QMH), (const bf16*)(ws + WS_KM), M, D, 256}; pg8::EpiSoftmax E{(bf16*)(ws + WS_P), M}; pg8::gemm_phase<pg8::EpiSoftmax, pg8::CrossOrder, false, true>(lds, g, S, E, wave); }
        __threadfence(); __syncthreads();
        { pg8::Gemm g{(const bf16*)(ws + WS_P), (const bf16*)(ws + WS_VTM), M, D, 256}; pg8::EpiBf16P E{(bf16*)(ws + WS_OM), D, 1.0f}; pg8::gemm_phase<pg8::EpiBf16P, pg8::CrossOrder, true, true>(lds, g, S, E, wave); }
    }
    SEAM(11);
    if (IN(12)) { PH_BEGIN; pg8::Gemm g{(const bf16*)(ws + WS_OM), (const bf16*)(ws + WS_WMO), M, D, D}; pg8::StaticOrder S; S.init(M, D, G, bx); pg8::EpiF32 E{(float*)(gb + GB_Z), D}; pg8::gemm_phase<pg8::EpiF32, pg8::StaticOrder, true, true>(lds, g, S, E, wave); }
    SEAM(12);
    if (IN(13)) { PH_BEGIN; rowpass<true, false>(P.out, (const float*)(gb + GB_Z), P.mempostg, 1.0f, P.out, P.f2g, (bf16*)(ws + WS_XN), nullptr, nullptr, nullptr, nullptr, lds, wave); }
    SEAM(13);
    if (IN(14)) { PH_BEGIN; pg8::Gemm g{(const bf16*)(ws + WS_XN), (const bf16*)(ws + WS_W2A), M, 2 * DFF, D}; pg8::StaticOrder S; S.init(M, 2 * DFF, G, bx); pg8::EpiSwiglu E{(bf16*)(ws + WS_HID), DFF};
        pg8::gemm_phase<pg8::EpiSwiglu, pg8::StaticOrder, true, true>(lds, g, S, E, wave); }
    SEAM(14);
    if (IN(15)) { PH_BEGIN; pg8::Gemm g{(const bf16*)(ws + WS_HID), (const bf16*)(ws + WS_W2D), M, D, DFF}; pg8::StaticOrder S; S.init(M, D, G, bx); pg8::EpiF32 E{(float*)(gb + GB_Z), D}; pg8::gemm_phase<pg8::EpiF32, pg8::StaticOrder, true, true>(lds, g, S, E, wave); }
    SEAM(15);
    if (IN(16)) { PH_BEGIN; rowpass<false, false>(P.out, (const float*)(gb + GB_Z), P.f2pg, 0.5f, P.out, nullptr, nullptr, nullptr, nullptr, nullptr, nullptr, lds, wave); }
#undef IN
#undef SEAM
#undef P
}

extern "C" void kernel_launch(void* const* d_in, const int* in_sizes, int n_in, void* d_out, int out_size, void* d_ws, size_t ws_size, hipStream_t stream) {
    static int grid = 0;
    if (grid == 0) {
        if (n_in != 26 || in_sizes[0] != M * D || out_size != M * D || ws_size < WS_END) { fprintf(stderr, "kernel_launch: unexpected problem (n_in %d, ws %zu)\n", n_in, ws_size); grid = -1; return; }
        int dev = 0, cus = 0, per_cu = 0;
        if (hipGetDevice(&dev) != hipSuccess || hipDeviceGetAttribute(&cus, hipDeviceAttributeMultiprocessorCount, dev) != hipSuccess) { grid = -1; return; }
        if (hipFuncSetAttribute((const void*)fwd, hipFuncAttributeMaxDynamicSharedMemorySize, LDS_BYTES) != hipSuccess) { fprintf(stderr, "kernel_launch: hipFuncSetAttribute failed\n"); grid = -1; return; }
        if (hipOccupancyMaxActiveBlocksPerMultiprocessor(&per_cu, (const void*)fwd, NT, LDS_BYTES) != hipSuccess || per_cu < 1) { fprintf(stderr, "kernel_launch: occupancy query gave %d\n", per_cu); (void)hipGetLastError(); grid = -1; return; }
        grid = cus * 1;
    }
    if (grid < 0) return;
    (void)hipMemsetAsync((char*)d_ws + WS_CTL, 0, CTL_ZERO_BYTES, stream);
    Ptrs p{};
    const float** pf = (const float**)&p;
    for (int i = 0; i < 26; ++i) pf[i] = (const float*)d_in[i];
    p.out = (float*)d_out; p.ws = (unsigned char*)d_ws;
#if ONE_LAUNCH
    p.ph_lo = 0; p.ph_hi = NPHASE;
    void* args[] = {&p};
    hipError_t e = hipLaunchCooperativeKernel((const void*)fwd, dim3(grid), dim3(NT), args, LDS_BYTES, stream);
    if (e != hipSuccess) fprintf(stderr, "cooperative launch failed: %s (grid %d)\n", hipGetErrorString(e), grid);
#else
    for (int k = 0; k < NPHASE; ++k) { p.ph_lo = k; p.ph_hi = k + 1; hipLaunchKernelGGL(fwd, dim3(grid), dim3(NT), LDS_BYTES, stream, p); }
#endif
}
```

```cpp
#include <hip/hip_runtime.h>
#include <hip/hip_cooperative_groups.h>
#include <cstdio>
#include <cstdint>
#include <cmath>
namespace cg = cooperative_groups;
__device__ __forceinline__ int fresh_lane() { int l; asm volatile("v_mbcnt_lo_u32_b32 %0, -1, 0\n\tv_mbcnt_hi_u32_b32 %0, -1, %0" : "=v"(l)); return l; }
namespace pg8 {
#define PG8_LAS __attribute__((address_space(3)))
typedef unsigned short bf16_t;
typedef short bf16x8 __attribute__((ext_vector_type(8)));
typedef float f32x4 __attribute__((ext_vector_type(4)));
typedef unsigned u32x4 __attribute__((ext_vector_type(4)));
constexpr int BM = 256, BK = 64, HALF = 128, HTB = HALF * BK * 2  , STAGE_BYTES = 8 * HTB, NXCD = 8, WGM = 8;

__host__ __device__ __forceinline__ int lds_byte(int r, int c) { const int st = (r >> 4) * 2 + (c >> 5), rr = r & 15, cc = c & 31, ob = rr * 64 + cc * 2; return st * 1024 + (ob ^ (((ob >> 9) & 1) << 5)); }
__host__ __device__ __forceinline__ void stage_rc(int b, int& R, int& C) { const int st = b / 1024, sb = b % 1024, swz = sb ^ (((sb >> 9) & 1) << 5); R = (st >> 1) * 16 + swz / 64; C = (st & 1) * 32 + (swz % 64) / 2; }
__host__ __device__ __forceinline__ int perm32(int rho) { const int n = rho >> 4, i = rho & 15; return 8 * (i >> 2) + 4 * n + (i & 3); }

struct Unit { int pm, pn; };
struct Gemm { const bf16_t* A; const bf16_t* Bt; int M, N, K; };

struct StaticOrder {
    int nM, nN, nwg, G, c;
    __host__ __device__ __forceinline__ void init(int M, int N, int G_, int c_) { nM = M / BM; nN = N / BM; nwg = nM * nN; G = G_; c = c_; }
    __host__ __device__ __forceinline__ bool next(int i, Unit& u) const {
        const long L = (long)i * G + c; if (L >= nwg) return false;
        int wgid = (int)L; { const int q = nwg / NXCD, r = nwg % NXCD, xcd = wgid % NXCD, off = wgid / NXCD; wgid = (xcd < r ? xcd * (q + 1) : r * (q + 1) + (xcd - r) * q) + off; }
        const int nig = WGM * nN, gid = wgid / nig, fm = gid * WGM, gsz = (nM - fm) < WGM ? (nM - fm) : WGM;
        u.pm = fm + ((wgid % nig) % gsz); u.pn = (wgid % nig) / gsz; return true;
    }
    __device__ __forceinline__ const char* pa(const Gemm& g, const Unit& u) const { return (const char*)g.A + (size_t)u.pm * ((size_t)BM * g.K * 2); }
    __device__ __forceinline__ const char* pb(const Gemm& g, const Unit& u) const { return (const char*)g.Bt + (size_t)u.pn * ((size_t)BM * g.K * 2); }
    __device__ __forceinline__ void a_ready(const Unit&) const {}
    __device__ __forceinline__ void done(const Unit&) const {}
};


struct ListOrder {
    int nM, c0, n, c;
    __device__ __forceinline__ bool next(int i, Unit& u) const { const int idx = c - c0; if (i != 0 || idx < 0 || idx >= n) return false; u.pm = idx % nM; u.pn = idx / nM; return true; }
    __device__ __forceinline__ const char* pa(const Gemm& g, const Unit& u) const { return (const char*)g.A + (size_t)u.pm * ((size_t)BM * g.K * 2); }
    __device__ __forceinline__ const char* pb(const Gemm& g, const Unit& u) const { return (const char*)g.Bt + (size_t)u.pn * ((size_t)BM * g.K * 2); }
    __device__ __forceinline__ void a_ready(const Unit&) const {}
    __device__ __forceinline__ void done(const Unit&) const {}
};
struct CrossOrder {
    StaticOrder so; int Mrows, pm_per_batch;
    __device__ __forceinline__ bool next(int i, Unit& u) const { return so.next(i, u); }
    __device__ __forceinline__ const char* pa(const Gemm& g, const Unit& u) const { return (const char*)g.A + ((size_t)u.pn * Mrows + (size_t)u.pm * BM) * ((size_t)g.K * 2); }
    __device__ __forceinline__ const char* pb(const Gemm& g, const Unit& u) const { return (const char*)g.Bt + ((size_t)(u.pn * 2 + u.pm / pm_per_batch) * BM) * ((size_t)g.K * 2); }
    __device__ __forceinline__ void a_ready(const Unit&) const {}
    __device__ __forceinline__ void done(const Unit&) const {}
};

__device__ __forceinline__ unsigned f2bf_(float f) { unsigned u = __builtin_bit_cast(unsigned, f); return (u + 0x7fffu + ((u >> 16) & 1u)) >> 16; }
typedef float f32x2e_ __attribute__((ext_vector_type(2)));
typedef __bf16 bf16x2e_ __attribute__((ext_vector_type(2)));
__device__ __forceinline__ unsigned pk2_(float lo, float hi) { const f32x2e_ v = {lo, hi}; return __builtin_bit_cast(unsigned, __builtin_convertvector(v, bf16x2e_)); }
__device__ __forceinline__ float bf2f_(unsigned v) { return __builtin_bit_cast(float, v << 16); }
typedef unsigned u32x2 __attribute__((ext_vector_type(2)));
__device__ __forceinline__ void st_bf4(bf16_t* p, f32x4 v) { u32x2 w; w.x = pk2_(v[0], v[1]); w.y = pk2_(v[2], v[3]); *(u32x2*)p = w; }
__device__ __forceinline__ f32x4 ld_bf4(const bf16_t* p) { const u32x2 w = *(const u32x2*)p; return (f32x4){bf2f_(w.x & 0xffffu), bf2f_(w.x >> 16), bf2f_(w.y & 0xffffu), bf2f_(w.y >> 16)}; }
__device__ __forceinline__ float sigm(float x) { return 1.0f / (1.0f + __expf(-x)); }
__device__ __forceinline__ float silu_(float x) { return x / (1.0f + __expf(-x)); }

#define PG8_FOREACH_BEGIN \
    _Pragma("unroll") for (int ai = 0; ai < 2; ++ai) _Pragma("unroll") for (int m = 0; m < 4; ++m) { const int row = u.pm * BM + ai * HALF + wr * 64 + m * 16 + fr; \
    _Pragma("unroll") for (int bj = 0; bj < 2; ++bj) { const int col = u.pn * BM + bj * HALF + wc * 32 + 8 * fq; const f32x4 v0 = acc[ai][bj][m][0], v1 = acc[ai][bj][m][1];
#define PG8_FOREACH_END } }
typedef unsigned u32x4e __attribute__((ext_vector_type(4)));
__device__ __forceinline__ void st_bf8(bf16_t* p, f32x4 a, f32x4 b) { u32x4e w; w.x = pk2_(a[0], a[1]); w.y = pk2_(a[2], a[3]); w.z = pk2_(b[0], b[1]); w.w = pk2_(b[2], b[3]); *(u32x4e*)p = w; }
__device__ __forceinline__ void ld_bf8(const bf16_t* p, f32x4& a, f32x4& b) { const u32x4e w = *(const u32x4e*)p; a = (f32x4){bf2f_(w.x & 0xffffu), bf2f_(w.x >> 16), bf2f_(w.y & 0xffffu), bf2f_(w.y >> 16)}; b = (f32x4){bf2f_(w.z & 0xffffu), bf2f_(w.z >> 16), bf2f_(w.w & 0xffffu), bf2f_(w.w >> 16)}; }
__device__ __forceinline__ f32x4 silu4(f32x4 v) { return (f32x4){silu_(v[0]), silu_(v[1]), silu_(v[2]), silu_(v[3])}; }
__device__ __forceinline__ f32x4 sigm4(f32x4 v) { return (f32x4){sigm(v[0]), sigm(v[1]), sigm(v[2]), sigm(v[3])}; }

struct EpiF32 {
    static constexpr bool PERM = true, AFTER_DRAIN = false; float* O; int ldc;
    __device__ __forceinline__ void operator()(const f32x4 (&acc)[2][2][4][2], const Unit& u, int wr, int wc, int fr, int fq) const {
        PG8_FOREACH_BEGIN *(f32x4*)(O + (size_t)row * ldc + col) = v0; *(f32x4*)(O + (size_t)row * ldc + col + 4) = v1; PG8_FOREACH_END
    }
};
struct EpiBf16P {
    static constexpr bool PERM = true, AFTER_DRAIN = false; bf16_t* O; int ldc; float sc;
    __device__ __forceinline__ void operator()(const f32x4 (&acc)[2][2][4][2], const Unit& u, int wr, int wc, int fr, int fq) const {
        PG8_FOREACH_BEGIN st_bf8(O + (size_t)row * ldc + col, v0 * sc, v1 * sc); PG8_FOREACH_END
    }
};
struct EpiSwiglu {
    static constexpr bool PERM = true, AFTER_DRAIN = false; bf16_t* O; int ldc;
    __device__ __forceinline__ void operator()(const f32x4 (&acc)[2][2][4][2], const Unit& u, int wr, int wc, int fr, int fq) const {
#pragma unroll
        for (int ai = 0; ai < 2; ++ai)
#pragma unroll
            for (int m = 0; m < 4; ++m) { const int row = u.pm * BM + ai * HALF + wr * 64 + m * 16 + fr; const int col = u.pn * HALF + wc * 32 + 8 * fq;
                st_bf8(O + (size_t)row * ldc + col, silu4(acc[ai][0][m][0]) * acc[ai][1][m][0], silu4(acc[ai][0][m][1]) * acc[ai][1][m][1]); }
    }
};
struct EpiInproj {
    static constexpr bool PERM = true, AFTER_DRAIN = false;
    bf16_t *QA, *LF, *GA, *QB, *KB, *GT; const float* lbl; const float* bgate; float qscale; int pn0;
    __device__ __forceinline__ void operator()(const f32x4 (&acc)[2][2][4][2], const Unit& u_, int wr, int wc, int fr, int fq) const {
        const Unit u{u_.pm, u_.pn + pn0};
        const int cls = u.pn >> 2;
        if (cls == 0 || cls == 2) { bf16_t* O = cls == 0 ? QA : GA; const int c0 = cls * 1024;
            PG8_FOREACH_BEGIN st_bf8(O + (size_t)row * 1024 + (col - c0), silu4(v0), silu4(v1)); PG8_FOREACH_END
        } else if (cls == 1) {
            PG8_FOREACH_BEGIN const int c = col - 1024; f32x4 o[2];
#pragma unroll
                for (int hh = 0; hh < 2; ++hh) { const f32x4 l0 = *(const f32x4*)(lbl + c + 4 * hh), l1 = *(const f32x4*)(lbl + 1024 + c + 4 * hh); const f32x4 v = hh ? v1 : v0;
#pragma unroll
                    for (int e = 0; e < 4; ++e) { const float lb = 1.0f / (1.0f + __expf(l1[e] - l0[e])); const float f = lb + (1.0f - lb) * sigm(v[e]); o[hh][e] = __logf(f); } }
                st_bf8(LF + (size_t)row * 1024 + c, o[0], o[1]); PG8_FOREACH_END
        } else if (cls == 3) {
            PG8_FOREACH_BEGIN st_bf8(QB + (size_t)row * 1024 + (col - 3072), v0 * qscale, v1 * qscale); PG8_FOREACH_END
        } else if (cls == 4) {
            PG8_FOREACH_BEGIN st_bf8(KB + (size_t)row * 1024 + (col - 4096), v0, v1); PG8_FOREACH_END
        } else {
            PG8_FOREACH_BEGIN const int c = col - 5120; const f32x4 bg0 = *(const f32x4*)(bgate + c), bg1 = *(const f32x4*)(bgate + c + 4);
                st_bf8(GT + (size_t)row * 2048 + c, sigm4(v0 + bg0), sigm4(v1 + bg1)); PG8_FOREACH_END
        }
    }
};
struct EpiBranchA {
    static constexpr bool PERM = true, AFTER_DRAIN = false; bf16_t* GT; const float* rstd;
    __device__ __forceinline__ void operator()(const f32x4 (&acc)[2][2][4][2], const Unit& u, int wr, int wc, int fr, int fq) const {
        const float* rs = rstd + (size_t)u.pn * 16384;
        PG8_FOREACH_BEGIN bf16_t* p = GT + (size_t)row * 2048 + col; f32x4 ga, gb_; ld_bf8(p, ga, gb_); const float r = rs[row]; st_bf8(p, ga * v0 * r, gb_ * v1 * r); PG8_FOREACH_END
    }
};
struct EpiBranchB {
    static constexpr bool PERM = true, AFTER_DRAIN = false; const bf16_t* GT; bf16_t* Y;
    __device__ __forceinline__ void operator()(const f32x4 (&acc)[2][2][4][2], const Unit& u, int wr, int wc, int fr, int fq) const {
        PG8_FOREACH_BEGIN const bf16_t* p = GT + (size_t)row * 2048 + col; f32x4 ta, tb, ga, gb_; ld_bf8(p, ta, tb); ld_bf8(p + 1024, ga, gb_); st_bf8(Y + (size_t)row * 1024 + col, ta + ga * v0, tb + gb_ * v1); PG8_FOREACH_END
    }
};
struct EpiHeadSplit {
    static constexpr bool PERM = true, AFTER_DRAIN = false; bf16_t* O; int Mrows; float sc;
    __device__ __forceinline__ void operator()(const f32x4 (&acc)[2][2][4][2], const Unit& u, int wr, int wc, int fr, int fq) const {
        PG8_FOREACH_BEGIN st_bf8(O + ((size_t)u.pn * Mrows + row) * 256 + (col - u.pn * BM), v0 * sc, v1 * sc); PG8_FOREACH_END
    }
};
#define PG8_FOREACH4_BEGIN \
    _Pragma("unroll") for (int ai = 0; ai < 2; ++ai) _Pragma("unroll") for (int m = 0; m < 4; ++m) { const int row = u.pm * BM + ai * HALF + wr * 64 + m * 16 + fr; \
    _Pragma("unroll") for (int bj = 0; bj < 2; ++bj) _Pragma("unroll") for (int n = 0; n < 2; ++n) { const int col = u.pn * BM + bj * HALF + wc * 32 + n * 16 + 4 * fq; const f32x4 v = acc[ai][bj][m][n];
#define PG8_FOREACH4_END } }
struct EpiMemKV {
    static constexpr bool PERM = false, AFTER_DRAIN = false; bf16_t *KM, *VTM;
    __device__ __forceinline__ void operator()(const f32x4 (&acc)[2][2][4][2], const Unit& u, int wr, int wc, int fr, int fq) const {
        if (u.pn < 4) { PG8_FOREACH4_BEGIN st_bf4(KM + ((size_t)u.pn * 512 + row) * 256 + (col - u.pn * BM), v); PG8_FOREACH4_END }
        else { const int h = u.pn - 4;
            PG8_FOREACH4_BEGIN const int d = col - u.pn * BM, b = row >> 8, key = row & 255; bf16_t* p = VTM + ((size_t)(h * 2 + b) * 256 + d) * 256 + key;
                p[0] = (bf16_t)f2bf_(v[0]); p[256] = (bf16_t)f2bf_(v[1]); p[512] = (bf16_t)f2bf_(v[2]); p[768] = (bf16_t)f2bf_(v[3]); PG8_FOREACH4_END }
    }
};
struct EpiSoftmax {
    static constexpr bool PERM = false, AFTER_DRAIN = true; bf16_t* P; int Mrows;
    __device__ __forceinline__ void fused(f32x4 (&acc)[2][2][4][2], const Unit& u, int wr, int wc, int fr, int fq, PG8_LAS unsigned char* lds, int wid, int lane) const {
        typedef float f32x2v __attribute__((ext_vector_type(2)));
        PG8_LAS f32x2v* X = (PG8_LAS f32x2v*)lds;
        float mx[2][4];
#pragma unroll
        for (int ai = 0; ai < 2; ++ai)
#pragma unroll
            for (int m = 0; m < 4; ++m) { float a = -INFINITY;
#pragma unroll
                for (int bj = 0; bj < 2; ++bj)
#pragma unroll
                    for (int n = 0; n < 2; ++n) { const f32x4 v = acc[ai][bj][m][n]; a = fmaxf(a, fmaxf(fmaxf(v[0], v[1]), fmaxf(v[2], v[3]))); }
                a = fmaxf(a, __shfl_xor(a, 16)); a = fmaxf(a, __shfl_xor(a, 32)); float s = 0.f;
#pragma unroll
                for (int bj = 0; bj < 2; ++bj)
#pragma unroll
                    for (int n = 0; n < 2; ++n) { const f32x4 v = acc[ai][bj][m][n]; s += (__builtin_amdgcn_exp2f(v[0] - a) + __builtin_amdgcn_exp2f(v[1] - a)) + (__builtin_amdgcn_exp2f(v[2] - a) + __builtin_amdgcn_exp2f(v[3] - a)); }
                s += __shfl_xor(s, 16); s += __shfl_xor(s, 32); mx[ai][m] = a;
                if (fq == 0) X[(ai * HALF + wr * 64 + m * 16 + fr) * 4 + wc] = (f32x2v){a, s}; }
        asm volatile("s_waitcnt lgkmcnt(0)" ::: "memory"); __builtin_amdgcn_s_barrier(); asm volatile("" ::: "memory");
#pragma unroll
        for (int ai = 0; ai < 2; ++ai)
#pragma unroll
            for (int m = 0; m < 4; ++m) { const int rl = ai * HALF + wr * 64 + m * 16 + fr; const f32x2v a = X[rl * 4 + 0], b = X[rl * 4 + 1], c = X[rl * 4 + 2], d = X[rl * 4 + 3];
                const float gm = fmaxf(fmaxf(a.x, b.x), fmaxf(c.x, d.x));
                const float gs = (a.y * __builtin_amdgcn_exp2f(a.x - gm) + b.y * __builtin_amdgcn_exp2f(b.x - gm)) + (c.y * __builtin_amdgcn_exp2f(c.x - gm) + d.y * __builtin_amdgcn_exp2f(d.x - gm));
                const float inv = 1.0f / gs; const int row = u.pm * BM + rl;
#pragma unroll
                for (int bj = 0; bj < 2; ++bj)
#pragma unroll
                    for (int n = 0; n < 2; ++n) { const int cl = bj * HALF + wc * 32 + n * 16 + 4 * fq; const f32x4 v = acc[ai][bj][m][n]; f32x4 p;
                        p[0] = __builtin_amdgcn_exp2f(v[0] - gm) * inv; p[1] = __builtin_amdgcn_exp2f(v[1] - gm) * inv; p[2] = __builtin_amdgcn_exp2f(v[2] - gm) * inv; p[3] = __builtin_amdgcn_exp2f(v[3] - gm) * inv;
                        st_bf4(P + ((size_t)u.pn * Mrows + row) * 256 + cl, p); } }
        (void)mx; (void)wid; (void)lane;
    }
};
template <class Epi, class Sched, bool ALIGN_EPI = false, bool SP2 = false>
__device__ __forceinline__ void gemm_phase(PG8_LAS unsigned char* lds, const Gemm g, const Sched& S, const Epi& E, const int wave_s) {
    const int lane = fresh_lane(), wid = wave_s, tid = wid * 64 + lane, wr = wid >> 2, wc = wid & 3, fr = lane & 15, fq = lane >> 4;
    const int K = g.K, nt = K / BK;
    unsigned voffA[2], voffB[2];
#pragma unroll
    for (int i = 0; i < 2; ++i) { int R, C; stage_rc(tid * 16 + i * 8192, R, C); const int Rb = Epi::PERM ? ((R & ~31) + perm32(R & 31)) : R;
        voffA[i] = (unsigned)(R * K + C) * 2u; voffB[i] = (unsigned)(Rb * K + C) * 2u; }
    const size_t kstep = (size_t)(BK * 2);
    const size_t hstep = (size_t)HALF * K * 2;
    const size_t tstep = 2 * hstep;
    const unsigned ldsw = (unsigned)wid * 1024u;
    const int aoff = lds_byte(wr * 64 + fr, fq * 8), boff = lds_byte(wc * 32 + fr, fq * 8);
#define PG8_SA(b, h) (((b) * 2 + (h)) * HTB)
#define PG8_SB(b, h) ((4 + (b) * 2 + (h)) * HTB)
#define PG8_STAGE(bufoff, gbase, voff) do { _Pragma("unroll") for (int _i = 0; _i < 2; ++_i) \
        __builtin_amdgcn_global_load_lds((const unsigned*)((const char*)(gbase) + (voff)[_i]), (PG8_LAS unsigned*)(lds + (bufoff) + ldsw + _i * 8192), 16, 0, 0); } while (0)
#define PG8_LDA(dst, b, h) do { _Pragma("unroll") for (int m = 0; m < 4; ++m) _Pragma("unroll") for (int k = 0; k < 2; ++k) dst[m][k] = *(const PG8_LAS bf16x8*)(lds + PG8_SA(b, h) + aoff + m * 2048 + k * 1024); } while (0)
#define PG8_LDB(dst, b, h) do { _Pragma("unroll") for (int n = 0; n < 2; ++n) _Pragma("unroll") for (int k = 0; k < 2; ++k) dst[n][k] = *(const PG8_LAS bf16x8*)(lds + PG8_SB(b, h) + boff + n * 2048 + k * 1024); } while (0)
#define PG8_MMA(ai, bj, At, Bt) do { __builtin_amdgcn_s_setprio(1); _Pragma("unroll") for (int m = 0; m < 4; ++m) _Pragma("unroll") for (int n = 0; n < 2; ++n) _Pragma("unroll") for (int k = 0; k < 2; ++k) \
        acc[ai][bj][m][n] = __builtin_amdgcn_mfma_f32_16x16x32_bf16(Bt[n][k], At[m][k], acc[ai][bj][m][n], 0, 0, 0); __builtin_amdgcn_s_setprio(0); } while (0)
#define PG8_WAIT_V(n) asm volatile("s_waitcnt vmcnt(" #n ")" ::: "memory")
#define PG8_WAIT_L(n) asm volatile("s_waitcnt lgkmcnt(" #n ")" ::: "memory")
#define PG8_BAR __builtin_amdgcn_s_barrier()
#define PG8_SCHED __builtin_amdgcn_sched_barrier(0)
    Unit cur, nxt; int ui = 0;
    if (!S.next(0, cur)) return;
    f32x4 acc[2][2][4][2];
#pragma unroll
    for (int a = 0; a < 2; ++a)
#pragma unroll
        for (int b = 0; b < 2; ++b)
#pragma unroll
            for (int m = 0; m < 4; ++m)
#pragma unroll
                for (int n = 0; n < 2; ++n) acc[a][b][m][n] = (f32x4){0.f, 0.f, 0.f, 0.f};
    bf16x8 At[4][2], B0[2][2], B1[2][2];
    const char* cA = S.pa(g, cur); const char* cB = S.pb(g, cur);
    S.a_ready(cur);
    if constexpr (SP2) {
        PG8_STAGE(PG8_SB(0, 0), cB, voffB); PG8_STAGE(PG8_SB(0, 1), cB + hstep, voffB); PG8_STAGE(PG8_SA(0, 0), cA, voffA); PG8_STAGE(PG8_SA(0, 1), cA + hstep, voffA);
        if (wr == 1) PG8_BAR;
        PG8_WAIT_V(2); PG8_BAR;
        PG8_STAGE(PG8_SB(1, 0), cB + kstep, voffB); PG8_STAGE(PG8_SA(1, 0), cA + kstep, voffA); PG8_STAGE(PG8_SB(1, 1), cB + hstep + kstep, voffB);
        PG8_WAIT_V(6); PG8_BAR;
    } else {
        PG8_STAGE(PG8_SB(0, 0), cB, voffB); PG8_STAGE(PG8_SA(0, 0), cA, voffA); PG8_STAGE(PG8_SB(0, 1), cB + hstep, voffB); PG8_STAGE(PG8_SA(0, 1), cA + hstep, voffA);
        if (wr == 1) PG8_BAR;
        PG8_WAIT_V(4); PG8_BAR;
        PG8_STAGE(PG8_SB(1, 0), cB + kstep, voffB); PG8_STAGE(PG8_SA(1, 0), cA + kstep, voffA); PG8_STAGE(PG8_SB(1, 1), cB + hstep + kstep, voffB);
        PG8_WAIT_V(6); PG8_BAR;
    }
    for (;;) {
        const bool has_next = S.next(ui + 1, nxt);
        const char* nA = has_next ? S.pa(g, nxt) : cA; const char* nB = has_next ? S.pb(g, nxt) : cB;
        for (int t = 0; t < nt; t += 2) {
            const bool last = (t == nt - 2);
            const char* a1 = cA + (size_t)(t + 1) * kstep;
            const char* a2 = last ? nA : cA + (size_t)(t + 2) * kstep; const char* b2 = last ? nB : cB + (size_t)(t + 2) * kstep;
            const char* a3 = a2 + kstep; const char* b3 = b2 + kstep;
            if (last && has_next) S.a_ready(nxt);
            if constexpr (SP2) {
            PG8_LDB(B0, 0, 0); PG8_LDB(B1, 0, 1); PG8_SCHED; PG8_LDA(At, 0, 0); PG8_STAGE(PG8_SA(1, 1), a1 + hstep, voffA);
            PG8_WAIT_V(8); PG8_WAIT_L(0); PG8_BAR; PG8_MMA(0, 0, At, B0); PG8_MMA(0, 1, At, B1); PG8_BAR; PG8_SCHED;
            PG8_LDA(At, 0, 1); PG8_STAGE(PG8_SB(0, 0), b2, voffB); PG8_STAGE(PG8_SB(0, 1), b2 + hstep, voffB); PG8_STAGE(PG8_SA(0, 0), a2, voffA);
            PG8_WAIT_V(8); PG8_WAIT_L(0); PG8_BAR; PG8_MMA(1, 0, At, B0); PG8_MMA(1, 1, At, B1); PG8_BAR; PG8_SCHED;
            PG8_LDB(B0, 1, 0); PG8_LDB(B1, 1, 1); PG8_SCHED; PG8_LDA(At, 1, 0); PG8_STAGE(PG8_SA(0, 1), a2 + hstep, voffA);
            PG8_WAIT_V(8); PG8_WAIT_L(0); PG8_BAR; PG8_MMA(0, 0, At, B0); PG8_MMA(0, 1, At, B1); PG8_BAR; PG8_SCHED;
            PG8_LDA(At, 1, 1); PG8_STAGE(PG8_SB(1, 0), b3, voffB); PG8_STAGE(PG8_SB(1, 1), b3 + hstep, voffB); PG8_STAGE(PG8_SA(1, 0), a3, voffA);
            PG8_WAIT_V(8); PG8_WAIT_L(0); PG8_BAR; PG8_MMA(1, 0, At, B0); PG8_MMA(1, 1, At, B1); PG8_BAR; PG8_SCHED;
            } else {
            PG8_LDB(B0, 0, 0); PG8_SCHED; PG8_LDA(At, 0, 0); PG8_STAGE(PG8_SA(1, 1), a1 + hstep, voffA);
            PG8_WAIT_L(8); PG8_BAR; PG8_WAIT_L(0); PG8_MMA(0, 0, At, B0); PG8_BAR; PG8_SCHED;
            PG8_LDB(B1, 0, 1); PG8_STAGE(PG8_SB(0, 0), b2, voffB);
            PG8_BAR; PG8_WAIT_L(0); PG8_MMA(0, 1, At, B1); PG8_BAR;
            PG8_LDA(At, 0, 1); PG8_STAGE(PG8_SA(0, 0), a2, voffA);
            PG8_BAR; PG8_WAIT_L(0); PG8_MMA(1, 0, At, B0); PG8_BAR; PG8_SCHED;
            PG8_STAGE(PG8_SB(0, 1), b2 + hstep, voffB);
            PG8_WAIT_V(6); PG8_BAR; PG8_MMA(1, 1, At, B1); PG8_BAR;
            PG8_LDB(B0, 1, 0); PG8_SCHED; PG8_LDA(At, 1, 0); PG8_STAGE(PG8_SA(0, 1), a2 + hstep, voffA);
            PG8_WAIT_L(8); PG8_BAR; PG8_WAIT_L(0); PG8_MMA(0, 0, At, B0); PG8_BAR; PG8_SCHED;
            PG8_LDB(B1, 1, 1); PG8_STAGE(PG8_SB(1, 0), b3, voffB);
            PG8_BAR; PG8_WAIT_L(0); PG8_MMA(0, 1, At, B1); PG8_BAR;
            PG8_LDA(At, 1, 1); PG8_STAGE(PG8_SA(1, 0), a3, voffA);
            PG8_BAR; PG8_WAIT_L(0); PG8_MMA(1, 0, At, B0); PG8_BAR; PG8_SCHED;
            PG8_STAGE(PG8_SB(1, 1), b3 + hstep, voffB);
            PG8_WAIT_V(6); PG8_BAR; PG8_MMA(1, 1, At, B1); PG8_BAR;
            }
        }
        if constexpr (ALIGN_EPI) { if (wr == 0) PG8_BAR; }
        if constexpr (!Epi::AFTER_DRAIN) { E(acc, cur, wr, wc, fr, fq); S.done(cur); }
        if (!has_next) break;
#pragma unroll
        for (int a = 0; a < 2; ++a)
#pragma unroll
            for (int b = 0; b < 2; ++b)
#pragma unroll
                for (int m = 0; m < 4; ++m)
#pragma unroll
                    for (int n = 0; n < 2; ++n) acc[a][b][m][n] = (f32x4){0.f, 0.f, 0.f, 0.f};
        cur = nxt; cA = nA; cB = nB; ++ui;
        if constexpr (ALIGN_EPI) { if (wr == 1) PG8_BAR; }
    }
    PG8_WAIT_V(0);
    if constexpr (!ALIGN_EPI) { if (wr == 0) PG8_BAR; }
    PG8_BAR;
    if constexpr (Epi::AFTER_DRAIN) { E.fused(acc, cur, wr, wc, fr, fq, lds, wid, lane); S.done(cur); }
#undef PG8_SA
#undef PG8_SB
#undef PG8_STAGE
#undef PG8_LDA
#undef PG8_LDB
#undef PG8_MMA
#undef PG8_WAIT_V
#undef PG8_WAIT_L
#undef PG8_BAR
#undef PG8_SCHED
}
}

constexpr int NW = 8, NT = NW * 64;
constexpr int BATCH = 2, SEQ = 8192, D = 1024, M = BATCH * SEQ, DFF = 2816, NH = 8, DH = 128, MEMLEN = 256, MROWS = BATCH * MEMLEN;
constexpr int IN_COLS = 9224;
constexpr float EPS = 1e-6f, LOG2E = 1.4426950408889634f;
constexpr int LDS_BYTES = 147456, RING_BYTES = 131072, MISC_OFF = RING_BYTES;
constexpr int NPHASE = 17;
#ifndef FOX_SKIP
#define FOX_SKIP 1
#endif
#ifndef ONE_LAUNCH
#define ONE_LAUNCH 1
#endif

constexpr size_t MiB = 1u << 20;
constexpr size_t WS_CTL = 0, CTL_ZERO_BYTES = 65536;
constexpr int CW_BAR = 4096;
constexpr size_t WS_WF = 1 * MiB;
constexpr size_t WS_LC = 1 * MiB + 64 * 1024;
constexpr size_t WS_BT = 1 * MiB + 640 * 1024;
constexpr size_t WS_RSTD = 1 * MiB + 704 * 1024;
constexpr size_t WS_KMAXP = 1 * MiB + 960 * 1024;
constexpr size_t WS_SSQ = 2 * MiB;
constexpr size_t WS_MEMN = 4 * MiB;
constexpr size_t WS_KM = 5 * MiB;
constexpr size_t WS_VTM = 6 * MiB;
constexpr size_t WS_W1A = 8 * MiB, WS_W1D = WS_W1A + 11 * MiB, WS_WIN = WS_W1D + 11 * MiB / 2, WS_WBA = WS_WIN + 18 * MiB, WS_WBB = WS_WBA + 2 * MiB, WS_WOUT = WS_WBB + 2 * MiB,
                 WS_WMQ = WS_WOUT + 2 * MiB, WS_WMO = WS_WMQ + 2 * MiB, WS_WMKV = WS_WMO + 2 * MiB, WS_W2A = WS_WMKV + 4 * MiB, WS_W2D = WS_W2A + 11 * MiB, WS_WEND = WS_W2D + 11 * MiB / 2;
static_assert(WS_WEND == 73 * MiB, "weights map");
constexpr size_t WS_XN = 74 * MiB;
constexpr size_t WS_R = 106 * MiB;
constexpr size_t WS_HID = WS_R;
constexpr size_t WS_QA = WS_R, WS_LF = WS_R + 32 * MiB, WS_IT = WS_R + 64 * MiB, WS_VT = WS_R + 96 * MiB;
constexpr size_t WS_Y = WS_R, WS_QMH = WS_R + 32 * MiB, WS_P = WS_R + 64 * MiB, WS_OM = WS_R + 96 * MiB;
constexpr size_t WS_D1 = 234 * MiB, WS_D2 = 235 * MiB;
constexpr size_t WS_END = 256 * MiB;
constexpr size_t GB_Z = 0, GB_GA = 0, GB_QB = 32 * MiB, GB_KB = 64 * MiB, GB_GT = 96 * MiB, GB_KHT = 160 * MiB, GB_BYTES = 192 * MiB;
__device__ __attribute__((aligned(256))) unsigned char g_buf[GB_BYTES];

#define LAS __attribute__((address_space(3)))
typedef unsigned short bf16;
typedef unsigned v4u __attribute__((ext_vector_type(4)));
typedef unsigned v2u __attribute__((ext_vector_type(2)));
typedef float f32x4 __attribute__((ext_vector_type(4)));
typedef float f32x16 __attribute__((ext_vector_type(16)));
typedef short bf16x8 __attribute__((ext_vector_type(8)));
__device__ __forceinline__ unsigned f2bf(float f) { unsigned u = __builtin_bit_cast(unsigned, f); return (u + 0x7fffu + ((u >> 16) & 1u)) >> 16; }
typedef float f32x2_ __attribute__((ext_vector_type(2)));
typedef __bf16 bf16x2_ __attribute__((ext_vector_type(2)));
__device__ __forceinline__ unsigned pk2(float lo, float hi) { const f32x2_ v = {lo, hi}; return __builtin_bit_cast(unsigned, __builtin_convertvector(v, bf16x2_)); }
__device__ __forceinline__ float bf2f(unsigned v) { return __builtin_bit_cast(float, v << 16); }
__device__ __forceinline__ float wave_sum(float v) {
#pragma unroll
    for (int o = 1; o < 64; o <<= 1) v += __shfl_xor(v, o);
    return v;
}
#define MFMA32(a, b, c) __builtin_amdgcn_mfma_f32_32x32x16_bf16((a), (b), (c), 0, 0, 0)
__device__ __forceinline__ int crow(int reg, int h) { return (reg & 3) + 8 * (reg >> 2) + 4 * h; }
__device__ __forceinline__ int prow(int m) { return (m & 0x13) | ((m & 4) << 1) | ((m & 8) >> 1); }
__device__ __forceinline__ bf16x8 pack8(const f32x16& x, int s) {
    v4u p; p.x = pk2(x[8 * s + 0], x[8 * s + 1]); p.y = pk2(x[8 * s + 2], x[8 * s + 3]); p.z = pk2(x[8 * s + 4], x[8 * s + 5]); p.w = pk2(x[8 * s + 6], x[8 * s + 7]);
    return __builtin_bit_cast(bf16x8, p);
}

struct Ptrs {
    const float *x, *mem, *f1g, *f1wi, *f1wd, *f1pg, *mixg, *win, *lbl, *hgg, *fbias, *wba, *wbb, *bgate, *wout, *mixpg, *mempg, *memkvg, *wmq, *wmkv, *wmo, *mempostg, *f2g, *f2wi, *f2wd, *f2pg;
    float* out; unsigned char* ws; int ph_lo, ph_hi;
};

__device__ __forceinline__ void transpose_item(const float* W, int K, int N, bf16* WT, int kb, int n_src, int n_dst, LAS float* scr, int lane) {
    const int k0 = 64 * kb;
    {
        const int r8 = lane >> 3, c4 = 4 * (lane & 7); f32x4 v[8];
#pragma unroll
        for (int i = 0; i < 8; ++i) v[i] = *(const f32x4*)(W + (size_t)(k0 + 8 * i + r8) * N + n_src + c4);
#pragma unroll
        for (int i = 0; i < 8; ++i) { LAS float* d = scr + (8 * i + r8) * 33 + c4; d[0] = v[i][0]; d[1] = v[i][1]; d[2] = v[i][2]; d[3] = v[i][3]; }
    }
    asm volatile("s_waitcnt lgkmcnt(0)" ::: "memory");
    const int c = lane & 7;
#pragma unroll
    for (int j = 0; j < 4; ++j) { const int n = (lane >> 3) + 8 * j; const LAS float* s = scr + (8 * c) * 33 + n;
        v4u o; o.x = pk2(s[0 * 33], s[1 * 33]); o.y = pk2(s[2 * 33], s[3 * 33]); o.z = pk2(s[4 * 33], s[5 * 33]); o.w = pk2(s[6 * 33], s[7 * 33]);
        *(v4u*)(WT + (size_t)(n_dst + n) * K + k0 + 8 * c) = o; }
    asm volatile("s_waitcnt lgkmcnt(0)" ::: "memory");
}
__device__ __forceinline__ void rms_row_to_bf16(const float* xrow, const float* g, bf16* orow, int lane) {
    const f32x4* xr = (const f32x4*)xrow + lane; const f32x4* gr = (const f32x4*)g + lane;
    f32x4 v[4]; float s = 0.f;
#pragma unroll
    for (int j = 0; j < 4; ++j) { v[j] = xr[64 * j]; s += (v[j][0] * v[j][0] + v[j][1] * v[j][1]) + (v[j][2] * v[j][2] + v[j][3] * v[j][3]); }
    const float rs = 1.0f / sqrtf(wave_sum(s) * (1.0f / D) + EPS);
    v2u* o8 = (v2u*)orow + lane;
#pragma unroll
    for (int j = 0; j < 4; ++j) { const f32x4 gg = gr[64 * j]; v2u w; w.x = pk2(v[j][0] * rs * gg[0], v[j][1] * rs * gg[1]); w.y = pk2(v[j][2] * rs * gg[2], v[j][3] * rs * gg[3]); o8[64 * j] = w; }
}

struct TItem { const float* W; int K, N; bf16* WT; int nblk; int kind; };
typedef const __attribute__((address_space(4))) Ptrs* KPtr0;
__device__ __forceinline__ void p0_prologue(KPtr0 KP, LAS unsigned char* lds, int wave) {
#define P (*KP)
    const int lane = fresh_lane();
    unsigned char* ws = P.ws;
    LAS float* scr = (LAS float*)(lds + wave * 16384);
    const int gw = blockIdx.x * NW + wave, NGW = gridDim.x * NW;
    constexpr int I_1A = 16 * 176, I_1D = 44 * 32, I_IN = 16 * 288, I_SQ = 16 * 32, I_KV = 16 * 64;
    constexpr int NITEMS = 2 * I_1A + 2 * I_1D + I_IN + 5 * I_SQ + I_KV;
    for (int it = gw; it < NITEMS; it += NGW) {
        int r = it; const float* W; int K, N, kind; bf16* WT;
        if (r < I_1A) { W = P.f1wi; K = D; N = 2 * DFF; WT = (bf16*)(ws + WS_W1A); kind = 1; }
        else if ((r -= I_1A) < I_1A) { W = P.f2wi; K = D; N = 2 * DFF; WT = (bf16*)(ws + WS_W2A); kind = 1; }
        else if ((r -= I_1A) < I_1D) { W = P.f1wd; K = DFF; N = D; WT = (bf16*)(ws + WS_W1D); kind = 0; }
        else if ((r -= I_1D) < I_1D) { W = P.f2wd; K = DFF; N = D; WT = (bf16*)(ws + WS_W2D); kind = 0; }
        else if ((r -= I_1D) < I_IN) { W = P.win; K = D; N = IN_COLS; WT = (bf16*)(ws + WS_WIN); kind = 2; }
        else if ((r -= I_IN) < I_SQ) { W = P.wba; K = D; N = D; WT = (bf16*)(ws + WS_WBA); kind = 0; }
        else if ((r -= I_SQ) < I_SQ) { W = P.wbb; K = D; N = D; WT = (bf16*)(ws + WS_WBB); kind = 0; }
        else if ((r -= I_SQ) < I_SQ) { W = P.wout; K = D; N = D; WT = (bf16*)(ws + WS_WOUT); kind = 0; }
        else if ((r -= I_SQ) < I_SQ) { W = P.wmq; K = D; N = D; WT = (bf16*)(ws + WS_WMQ); kind = 0; }
        else if ((r -= I_SQ) < I_SQ) { W = P.wmo; K = D; N = D; WT = (bf16*)(ws + WS_WMO); kind = 0; }
        else { r -= I_SQ; W = P.wmkv; K = D; N = 2 * D; WT = (bf16*)(ws + WS_WMKV); kind = 0; }
        int ndb = (kind == 2) ? 288 : N / 32;
        const int kb = r / ndb, nb = r % ndb; const int n_dst = 32 * nb; int n_src = n_dst;
        if (kind == 1) { const int tile = n_dst >> 8, w = n_dst & 255; n_src = (w < 128) ? (tile * 128 + w) : (DFF + tile * 128 + (w - 128)); }
        else if (kind == 2) {
            const int seg = n_dst >> 10, w = n_dst & 1023;
            const int srcbase = (seg == 0) ? 0 : (seg == 1) ? 1024 : (seg == 2) ? 3072 : (seg == 3) ? 4096 : (seg == 4) ? 5120 : (seg == 5) ? 7176 : (seg == 6) ? 8200 : (seg == 7) ? 2048 : 6144;
            n_src = srcbase + w; }
        transpose_item(W, K, N, WT, kb, n_src, n_dst, scr, lane);
    }
    { float* WF = (float*)(ws + WS_WF); const int gt = blockIdx.x * NT + wave * 64 + lane; if (gt < 8 * 1024) { const int j = gt >> 10, k = gt & 1023; WF[gt] = P.win[(size_t)k * IN_COLS + 7168 + j]; } }
    bf16* XN = (bf16*)(ws + WS_XN); bf16* MEMN = (bf16*)(ws + WS_MEMN);
    for (int m = gw; m < M; m += NGW) rms_row_to_bf16(P.x + (size_t)m * D, P.f1g, XN + (size_t)m * D, lane);
    for (int m = gw; m < MROWS; m += NGW) rms_row_to_bf16(P.mem + (size_t)m * D, P.memkvg, MEMN + (size_t)m * D, lane);
#undef P
}

template <bool HAS_XN, bool FB>
__device__ __forceinline__ void rowpass(const float* xin, const bf16* Z, const float* gpost, float coef, float* xout, const float* gpre, bf16* XN,
                                        const float* WF, const float* fbias, float* LC, float* BT, LAS unsigned char* lds, int wave) {
    const int lane = fresh_lane(), tid = wave * 64 + lane;
    LAS float* lsf = (LAS float*)lds;
    for (int blk = blockIdx.x; blk < M / 64; blk += gridDim.x) {
        for (int rr = 0; rr < 8; ++rr) {
            const int rl = wave * 8 + rr; const size_t row = (size_t)blk * 64 + rl;
            const v2u* zr = (const v2u*)(Z + row * D) + lane; const f32x4* xr = (const f32x4*)(xin + row * D) + lane; f32x4* xo = (f32x4*)(xout + row * D) + lane;
            f32x4 z[4], xv[4]; float s = 0.f;
#pragma unroll
            for (int j = 0; j < 4; ++j) { const v2u zw = zr[64 * j]; z[j] = (f32x4){bf2f(zw.x & 0xffffu), bf2f(zw.x >> 16), bf2f(zw.y & 0xffffu), bf2f(zw.y >> 16)}; xv[j] = xr[64 * j]; s += (z[j][0] * z[j][0] + z[j][1] * z[j][1]) + (z[j][2] * z[j][2] + z[j][3] * z[j][3]); }
            const float rs = coef / sqrtf(wave_sum(s) * (1.0f / D) + EPS); float s2 = 0.f;
#pragma unroll
            for (int j = 0; j < 4; ++j) { const f32x4 gg = ((const f32x4*)gpost + lane)[64 * j]; xv[j] = xv[j] + z[j] * gg * rs; xo[64 * j] = xv[j];
                s2 += (xv[j][0] * xv[j][0] + xv[j][1] * xv[j][1]) + (xv[j][2] * xv[j][2] + xv[j][3] * xv[j][3]); }
            if (HAS_XN) {
                const float rs2 = 1.0f / sqrtf(wave_sum(s2) * (1.0f / D) + EPS);
                v2u* o8 = (v2u*)(XN + row * D) + lane;
#pragma unroll
                for (int j = 0; j < 4; ++j) { const f32x4 gg = ((const f32x4*)gpre + lane)[64 * j]; xv[j] = xv[j] * gg * rs2; v2u w; w.x = pk2(xv[j][0], xv[j][1]); w.y = pk2(xv[j][2], xv[j][3]); o8[64 * j] = w; }
                if (FB) {
#pragma unroll
                    for (int h = 0; h < 8; ++h) { float d = 0.f;
#pragma unroll
                        for (int j = 0; j < 4; ++j) { const f32x4 w = ((const f32x4*)(WF + h * 1024) + lane)[64 * j]; d += (xv[j][0] * w[0] + xv[j][1] * w[1]) + (xv[j][2] * w[2] + xv[j][3] * w[3]); }
                        d = wave_sum(d) + fbias[h];
                        const float ls = fminf(d, 0.f) - log1pf(__expf(-fabsf(d)));
                        if (lane == 0) lsf[rl * 8 + h] = ls; }
                }
            }
        }
        if (FB) {
            __syncthreads();
            if (tid < 8) { const int h = tid; float run = 0.f;
                for (int r = 0; r < 64; ++r) { run += lsf[r * 8 + h]; LC[((size_t)blk * 64 + r) * 8 + h] = run; }
                BT[blk * 8 + h] = run; }
            __syncthreads();
        }
    }
}

namespace fox {
constexpr int KSTR = 272, VSTR = 144, KBYTES = 64 * KSTR, VBYTES = 128 * VSTR, BUFB = KBYTES + VBYTES, CK_OFF = 2 * BUFB, CPRE_OFF = CK_OFF + 512, CE_OFF = CPRE_OFF + 512, RED_OFF = CE_OFF + 512, FLG_OFF = RED_OFF + 512, KMX_OFF = FLG_OFF + 64;
static_assert(KMX_OFF + 16 <= RING_BYTES, "fox lds");
__device__ __forceinline__ void unit(LAS unsigned char* lds, int u, bf16* QB, const bf16* KB, const bf16* VT, const float* LC, const float* BT, const float* KMAXP, int wave) {
    const int lane = fresh_lane(), tid = wave * 64 + lane;
    const int bh = u & 15, qblk = 31 - (u >> 4), b = bh >> 3, h = bh & 7;
    const int half = lane >> 5, l31 = lane & 31;
    LAS float* ck = (LAS float*)(lds + CK_OFF); LAS float* cpre = (LAS float*)(lds + CPRE_OFF); LAS float* ce = (LAS float*)(lds + CE_OFF); LAS float* red = (LAS float*)(lds + RED_OFF);
    LAS unsigned* flg = (LAS unsigned*)(lds + FLG_OFF); LAS float* kmx = (LAS float*)(lds + KMX_OFF);
    const int ntiles = 4 * (qblk + 1);
    if (tid < 128) { float s = 0.f; for (int j = 0; j < tid; ++j) s += BT[(b * 128 + j) * 8 + h]; cpre[tid] = s; red[tid] = KMAXP[(b * 128 + tid) * 8 + h]; }
    if (tid < 16) flg[tid] = 0u;
    const int qs = qblk * 256 + 32 * wave + l31;
    const size_t qtok = (size_t)b * SEQ + qs;
    bf16x8 qf[8]; float qn2 = 0.f;
#pragma unroll
    for (int ks = 0; ks < 8; ++ks) { qf[ks] = *(const bf16x8*)(QB + qtok * 1024 + h * 128 + 16 * ks + 8 * half);
#pragma unroll
        for (int e = 0; e < 8; ++e) { const float v = bf2f((unsigned)(unsigned short)qf[ks][e]); qn2 += v * v; } }
    qn2 += __shfl_xor(qn2, 32);
    __syncthreads();
    if (wave == 0) { float m = fmaxf(red[lane], red[lane + 64]);
#pragma unroll
        for (int o = 1; o < 64; o <<= 1) m = fmaxf(m, __shfl_xor(m, o));
        if (lane == 0) kmx[0] = m; }
    if (tid < ntiles) ce[tid] = (LC[((size_t)b * SEQ + 64 * tid + 63) * 8 + h] + cpre[tid]) * LOG2E;
    const float cq = (LC[qtok * 8 + h] + cpre[qs >> 6]) * LOG2E;
    v4u kr[2], vr[2]; float ckr = 0.f;
    const int krow_[2] = {tid >> 4, (tid + 512) >> 4}, kc16 = tid & 15;
    const int vrow_[2] = {tid >> 3, (tid + 512) >> 3}, vc16 = tid & 7;
#define FOX_LOAD(t) do { const size_t k0 = (size_t)b * SEQ + 64 * (t); \
        _Pragma("unroll") for (int i = 0; i < 2; ++i) { kr[i] = *(const v4u*)(KB + (k0 + krow_[i]) * 1024 + h * 128 + 8 * kc16); vr[i] = *(const v4u*)(VT + (size_t)(h * 128 + vrow_[i]) * M + k0 + 8 * vc16); } \
        if (tid < 64) ckr = (LC[(k0 + tid) * 8 + h] + cpre[(t)]) * LOG2E; } while (0)
#define FOX_STORE(buf) do { LAS unsigned char* Kl = lds + (buf) * BUFB; LAS unsigned char* Vl = Kl + KBYTES; \
        _Pragma("unroll") for (int i = 0; i < 2; ++i) { *(LAS v4u*)(Kl + krow_[i] * KSTR + 16 * kc16) = kr[i]; *(LAS v4u*)(Vl + vrow_[i] * VSTR + 16 * vc16) = vr[i]; } \
        if (tid < 64) ck[(buf) * 64 + tid] = ckr; } while (0)
    FOX_LOAD(ntiles - 1); FOX_STORE(0);
    __syncthreads();
    const float qk_ub = sqrtf(qn2) * sqrtf(kmx[0]) * 1.02f;
    f32x16 o[4];
#pragma unroll
    for (int rb = 0; rb < 4; ++rb)
#pragma unroll
        for (int i = 0; i < 16; ++i) o[rb][i] = 0.f;
    float mrun = -INFINITY, lrun = 0.f;
    const int qmin = qblk * 256 + 32 * wave;
    const int kperm = prow(l31);
    for (int st = 0; st < ntiles; ++st) {
        const int t = ntiles - 1 - st, buf = st & 1;
#if FOX_SKIP
        if (st > 0) { const LAS unsigned* f = flg + ((st - 1) & 1) * 8; const unsigned all = f[0] & f[1] & f[2] & f[3] & f[4] & f[5] & f[6] & f[7]; if (all) break; }
#endif
        if (t > 0) FOX_LOAD(t - 1);
        const int kpos0 = 64 * t;
        if (kpos0 <= qmin + 31) {
            const bool full = (kpos0 + 63 <= qmin);
            LAS unsigned char* Kl = lds + buf * BUFB; LAS unsigned char* Vl = Kl + KBYTES;
            f32x16 s[2];
#pragma unroll
            for (int blk = 0; blk < 2; ++blk) {
#pragma unroll
                for (int i = 0; i < 16; ++i) s[blk][i] = 0.f;
#pragma unroll
                for (int ks = 0; ks < 8; ++ks) { const bf16x8 a = *(const LAS bf16x8*)(Kl + (32 * blk + kperm) * KSTR + 32 * ks + 16 * half); s[blk] = MFMA32(a, qf[ks], s[blk]); }
            }
            float mx = -INFINITY;
#pragma unroll
            for (int blk = 0; blk < 2; ++blk)
#pragma unroll
                for (int g = 0; g < 2; ++g) { const int key0 = 32 * blk + 16 * g + 8 * half; const f32x4 c0 = *(const LAS f32x4*)(ck + buf * 64 + key0), c1 = *(const LAS f32x4*)(ck + buf * 64 + key0 + 4);
#pragma unroll
                    for (int e = 0; e < 8; ++e) { const int i = 8 * g + e; float sc = s[blk][i] + (cq - (e < 4 ? c0[e & 3] : c1[e & 3]));
                        if (!full && (kpos0 + key0 + e > qs)) sc = -INFINITY;
                        s[blk][i] = sc; mx = fmaxf(mx, sc); } }
            mx = fmaxf(mx, __shfl_xor(mx, 32));
            const float mnew = fmaxf(mrun, mx), alpha = __builtin_amdgcn_exp2f(mrun - mnew); mrun = mnew;
            float ps = 0.f;
#pragma unroll
            for (int blk = 0; blk < 2; ++blk)
#pragma unroll
                for (int i = 0; i < 16; ++i) { const float p = __builtin_amdgcn_exp2f(s[blk][i] - mnew); s[blk][i] = p; ps += p; }
            lrun = lrun * alpha + ps;
#pragma unroll
            for (int rb = 0; rb < 4; ++rb)
#pragma unroll
                for (int i = 0; i < 16; ++i) o[rb][i] *= alpha;
            bf16x8 pf[4];
#pragma unroll
            for (int k4 = 0; k4 < 4; ++k4) pf[k4] = pack8(s[k4 >> 1], k4 & 1);
#pragma unroll
            for (int rb = 0; rb < 4; ++rb)
#pragma unroll
                for (int k4 = 0; k4 < 4; ++k4) { const bf16x8 a = *(const LAS bf16x8*)(Vl + (32 * rb + l31) * VSTR + 32 * k4 + 16 * half); o[rb] = MFMA32(a, pf[k4], o[rb]); }
        }
#if FOX_SKIP
        {
            bool ok = false;
            if (t > 0) ok = (qk_ub + (cq - ce[t - 1]) < mrun - 150.0f);
            const bool wave_ok = __builtin_amdgcn_ballot_w64(ok) == ~0ull;
            if (lane == 0) flg[(st & 1) * 8 + wave] = wave_ok ? 1u : 0u;
        }
#endif
        if (t > 0) FOX_STORE(buf ^ 1);
        __syncthreads();
    }
    const float ltot = lrun + __shfl_xor(lrun, 32), inv = 1.0f / ltot;
    bf16* orow = QB + qtok * 1024 + h * 128;
#pragma unroll
    for (int rb = 0; rb < 4; ++rb)
#pragma unroll
        for (int g = 0; g < 4; ++g) { v2u w; w.x = pk2(o[rb][4 * g] * inv, o[rb][4 * g + 1] * inv); w.y = pk2(o[rb][4 * g + 2] * inv, o[rb][4 * g + 3] * inv);
            *(v2u*)(orow + 32 * rb + 8 * g + 4 * half) = w; }
    __syncthreads();
#undef FOX_LOAD
#undef FOX_STORE
}
__device__ __forceinline__ void kmax_block(LAS unsigned char* lds, int w, const bf16* KB, float* KMAXP, int wave) {
    const int lane = fresh_lane(); LAS float* red = (LAS float*)lds;
    float mx = 0.f;
    for (int i = 0; i < 8; ++i) { const size_t tok = (size_t)w * 64 + wave * 8 + i; const v4u a = *(const v4u*)(KB + tok * 1024 + 16 * lane), c = *(const v4u*)(KB + tok * 1024 + 16 * lane + 8); float s = 0.f;
#pragma unroll
        for (int e = 0; e < 4; ++e) { const float x0 = bf2f(a[e] & 0xffffu), x1 = bf2f(a[e] >> 16), y0 = bf2f(c[e] & 0xffffu), y1 = bf2f(c[e] >> 16); s += (x0 * x0 + x1 * x1) + (y0 * y0 + y1 * y1); }
        s += __shfl_xor(s, 1); s += __shfl_xor(s, 2); s += __shfl_xor(s, 4); mx = fmaxf(mx, s); }
    if ((lane & 7) == 0) red[wave * 8 + (lane >> 3)] = mx;
    __syncthreads();
    if (wave == 0 && lane < 8) { float m = red[lane];
#pragma unroll
        for (int j = 1; j < 8; ++j) m = fmaxf(m, red[j * 8 + lane]);
        KMAXP[w * 8 + lane] = m; }
    __syncthreads();
}
}

namespace hg {
constexpr int RS = 272;
constexpr int IMG_BYTES = 2 * 64 * RS, QH_OFF = 0, KH_OFF = 64 * RS, ST_OFF = 2 * IMG_BYTES, ST_BYTES = 32 * RS, OP_OFF = ST_OFF + 2 * ST_BYTES, OP_BYTES = 4096, OI_OFF = OP_OFF + 2 * OP_BYTES, OI_BYTES = 8192,
              END_OFF = OI_OFF + 2 * OI_BYTES;
static_assert(END_OFF <= RING_BYTES, "hgrn lds");
__device__ __forceinline__ void prepass_item(LAS unsigned char* lds, int item, bf16* QA, bf16* LF, bf16* KHT, float* D1, float* D2, int wave) {
    const int lane = fresh_lane(), tid = wave * 64 + lane;
    const int b = item >> 10, h = (item >> 7) & 7, n = item & 127;
    const int c = tid & 127, tg = tid >> 7;
    LAS float* GTOT = (LAS float*)lds;
    const size_t t0 = (size_t)b * SEQ + 64 * n + 16 * tg;
    float lf[16], bl[16], qv[16]; float run = 0.f;
#pragma unroll
    for (int k = 0; k < 16; ++k) { lf[k] = bf2f(LF[(t0 + k) * 1024 + h * 128 + c]); qv[k] = bf2f(QA[(t0 + k) * 1024 + h * 128 + c]); }
#pragma unroll
    for (int k = 0; k < 16; ++k) { run += lf[k]; bl[k] = run; }
    GTOT[tg * 128 + c] = run;
    __syncthreads();
    const float g0 = GTOT[c], g1 = GTOT[128 + c], g2 = GTOT[256 + c], g3 = GTOT[384 + c];
    const float off = (tg > 0 ? g0 : 0.f) + (tg > 1 ? g1 : 0.f) + (tg > 2 ? g2 : 0.f);
    const float b31 = g0 + g1, b63 = b31 + g2 + g3;
    unsigned kt[8];
#pragma unroll
    for (int k = 0; k < 16; k += 2) { float qh[2], kk[2];
#pragma unroll
        for (int e = 0; e < 2; ++e) { const float bp = off + bl[k + e] - b31; qh[e] = qv[k + e] * __expf(bp); kk[e] = (1.0f - __expf(lf[k + e])) * __expf(-bp); }
        const unsigned qp = pk2(qh[0], qh[1]), kp2 = pk2(kk[0], kk[1]);
        const size_t a = (t0 + k) * 1024 + h * 128 + c;
        QA[a] = (bf16)(qp & 0xffffu); QA[a + 1024] = (bf16)(qp >> 16); LF[a] = (bf16)(kp2 & 0xffffu); LF[a + 1024] = (bf16)(kp2 >> 16);
        kt[k >> 1] = kp2; }
    v4u* kp = (v4u*)(KHT + (size_t)(h * 128 + c) * M + t0);
    kp[0] = (v4u){kt[0], kt[1], kt[2], kt[3]}; kp[1] = (v4u){kt[4], kt[5], kt[6], kt[7]};
    if (tg == 0) { const size_t di = (size_t)(b * 128 + n) * 1024 + h * 128 + c; D1[di] = __expf(b31); D2[di] = __expf(b63 - b31); }
    __syncthreads();
}
__device__ __forceinline__ void unit(LAS unsigned char* lds, int u, const bf16* QH, const bf16* KH, const bf16* KHT, const float* D1, const float* D2, const bf16* IT, bf16* GA, const float* hgg, float* SSQ, int wave) {
    const int lane = fresh_lane(), tid = wave * 64 + lane;
    const int b = u >> 5, h = (u >> 2) & 7, vs = u & 3;
    const int half = lane >> 5, l31 = lane & 31;
    const size_t tok0 = (size_t)b * SEQ;
    constexpr int NCH = SEQ / 64;
    for (int i = tid; i < ST_BYTES / 4; i += NT) ((LAS unsigned*)(lds + ST_OFF))[i] = 0u;
    f32x16 S, oa;
#pragma unroll
    for (int i = 0; i < 16; ++i) { S[i] = 0.f; oa[i] = 0.f; }
    v4u sr[2][2]; bf16x8 itn[4], khn[4]; float d1n = 0.f, d2n = 0.f, d1nn = 0.f, d2nn = 0.f; v2u gan[4], gap[4];
    const int srow[2] = {tid >> 4, (tid + 512) >> 4}, sc16 = tid & 15;
    const bf16* itrow = IT + (size_t)(h * 128 + 32 * vs + l31) * M + tok0 + 8 * half;
    const int cc = 32 * (wave & 3) + l31;
    const bf16* khtrow = KHT + (size_t)(h * 128 + cc) * M + tok0 + 8 * half;
    const int tbw = wave & 1;
    f32x4 gnv[4];
#pragma unroll
    for (int g = 0; g < 4; ++g) { gnv[g] = *(const f32x4*)(hgg + h * 128 + 32 * vs + 8 * g + 4 * half); gap[g] = (v2u){0u, 0u}; gan[g] = (v2u){0u, 0u}; }
#define HG_STAGE_LOAD(n) do { _Pragma("unroll") for (int i = 0; i < 2; ++i) { const size_t a = (tok0 + 64 * (n) + srow[i]) * 1024 + h * 128 + 8 * sc16; \
        sr[0][i] = *(const v4u*)(QH + a); sr[1][i] = *(const v4u*)(KH + a); } } while (0)
#define HG_STAGE_STORE(buf) do { LAS unsigned char* I_ = lds + (buf) * IMG_BYTES; _Pragma("unroll") for (int i = 0; i < 2; ++i) { \
        *(LAS v4u*)(I_ + QH_OFF + srow[i] * RS + 16 * sc16) = sr[0][i]; *(LAS v4u*)(I_ + KH_OFF + srow[i] * RS + 16 * sc16) = sr[1][i]; } } while (0)
#define HG_D_LOAD(n, d1v, d2v) do { if (wave < 4 && (n) < NCH) { const size_t di = (size_t)(b * 128 + (n)) * 1024 + h * 128 + cc; d1v = D1[di]; d2v = D2[di]; } } while (0)
#define HG_ROLE_LOAD(n) do { if (wave < 7) { _Pragma("unroll") for (int ks = 0; ks < 4; ++ks) itn[ks] = *(const bf16x8*)(itrow + 64 * (n) + 16 * ks); } \
        if (wave < 4) { _Pragma("unroll") for (int ks = 0; ks < 4; ++ks) khn[ks] = *(const bf16x8*)(khtrow + 64 * (n) + 16 * ks); } \
        else if (wave < 6) { const bf16* gp_ = GA + (tok0 + 64 * (n) + 32 * tbw + l31) * 1024 + h * 128 + 32 * vs; _Pragma("unroll") for (int g = 0; g < 4; ++g) gan[g] = *(const v2u*)(gp_ + 8 * g + 4 * half); } } while (0)
#define HG_FINAL(nn) do { LAS float* OIp = (LAS float*)(lds + OI_OFF + ((nn) & 1) * OI_BYTES) + tbw * 1024; LAS float* OPp = (LAS float*)(lds + OP_OFF + ((nn) & 1) * OP_BYTES); \
        const size_t tok = tok0 + 64 * (nn) + 32 * tbw + l31; float ssq = 0.f; bf16* gp = GA + tok * 1024 + h * 128 + 32 * vs; \
        _Pragma("unroll") for (int g = 0; g < 4; ++g) { float a_[4]; \
            _Pragma("unroll") for (int e = 0; e < 4; ++e) { const int i = 4 * g + e; float v_ = oa[i] + OIp[i * 64 + lane]; if (tbw) v_ += OPp[i * 64 + lane]; a_[e] = v_; } \
            ssq += (a_[0] * a_[0] + a_[1] * a_[1]) + (a_[2] * a_[2] + a_[3] * a_[3]); const v2u gw = gap[g]; const f32x4 gn = gnv[g]; \
            v2u w; w.x = pk2(a_[0] * gn[0] * bf2f(gw.x & 0xffffu), a_[1] * gn[1] * bf2f(gw.x >> 16)); w.y = pk2(a_[2] * gn[2] * bf2f(gw.y & 0xffffu), a_[3] * gn[3] * bf2f(gw.y >> 16)); \
            *(v2u*)(gp + 8 * g + 4 * half) = w; } \
        ssq += __shfl_xor(ssq, 32); if (half == 0) SSQ[tok * 32 + h * 4 + vs] = ssq; } while (0)
    HG_STAGE_LOAD(0); HG_ROLE_LOAD(0); HG_D_LOAD(0, d1n, d2n); HG_D_LOAD(1, d1nn, d2nn); HG_STAGE_STORE(0);
    __syncthreads();
    const int kp = prow(l31);
    for (int n = 0; n < NCH; ++n) {
        bf16x8 itc[4], khc[4]; v2u gac[4]; const float d1 = d1n, d2 = d2n;
#pragma unroll
        for (int ks = 0; ks < 4; ++ks) { itc[ks] = itn[ks]; khc[ks] = khn[ks]; gac[ks] = gan[ks]; }
        d1n = d1nn; d2n = d2nn;
        if (n + 1 < NCH) { HG_STAGE_LOAD(n + 1); HG_ROLE_LOAD(n + 1); }
        HG_D_LOAD(n + 2, d1nn, d2nn);
        LAS unsigned char* IM = lds + (n & 1) * IMG_BYTES;
        LAS unsigned char* STc = lds + ST_OFF + (n & 1) * ST_BYTES; LAS unsigned char* STn = lds + ST_OFF + ((n + 1) & 1) * ST_BYTES;
        if (wave < 4) {
            f32x16 acc;
#pragma unroll
            for (int i = 0; i < 16; ++i) acc[i] = S[i] * d1;
#pragma unroll
            for (int ks = 0; ks < 4; ++ks) acc = MFMA32(itc[ks], khc[ks], acc);
#pragma unroll
            for (int i = 0; i < 16; i += 2) { S[i] = acc[i] * d2; S[i + 1] = acc[i + 1] * d2; const unsigned w = pk2(S[i] * d1n, S[i + 1] * d1n);
                *(LAS unsigned short*)(STn + crow(i, half) * RS + 2 * cc) = (unsigned short)(w & 0xffffu); *(LAS unsigned short*)(STn + crow(i + 1, half) * RS + 2 * cc) = (unsigned short)(w >> 16); }
        } else if (wave < 6) {
            if (n > 0) HG_FINAL(n - 1);
            const int t = 32 * tbw + l31;
            f32x16 am;
#pragma unroll
            for (int i = 0; i < 16; ++i) am[i] = 0.f;
#pragma unroll
            for (int ks = 0; ks < 8; ++ks) { const bf16x8 a = *(const LAS bf16x8*)(IM + KH_OFF + (32 * tbw + kp) * RS + 32 * ks + 16 * half); const bf16x8 q = *(const LAS bf16x8*)(IM + QH_OFF + t * RS + 32 * ks + 16 * half); am = MFMA32(a, q, am); }
#pragma unroll
            for (int i = 0; i < 16; ++i) { const int s = 16 * (i >> 3) + 8 * half + (i & 7); if (s > l31) am[i] = 0.f; }
            const bf16x8 p0 = pack8(am, 0), p1 = pack8(am, 1);
#pragma unroll
            for (int i = 0; i < 16; ++i) oa[i] = 0.f;
            if (tbw == 0) { oa = MFMA32(itc[0], p0, oa); oa = MFMA32(itc[1], p1, oa); } else { oa = MFMA32(itc[2], p0, oa); oa = MFMA32(itc[3], p1, oa); }
#pragma unroll
            for (int g = 0; g < 4; ++g) gap[g] = gac[g];
        } else if (wave == 6) {
            const int t = 32 + l31;
            f32x16 am, o;
#pragma unroll
            for (int i = 0; i < 16; ++i) { am[i] = 0.f; o[i] = 0.f; }
#pragma unroll
            for (int ks = 0; ks < 8; ++ks) { const bf16x8 a = *(const LAS bf16x8*)(IM + KH_OFF + kp * RS + 32 * ks + 16 * half); const bf16x8 q = *(const LAS bf16x8*)(IM + QH_OFF + t * RS + 32 * ks + 16 * half); am = MFMA32(a, q, am); }
            const bf16x8 p0 = pack8(am, 0), p1 = pack8(am, 1);
            o = MFMA32(itc[0], p0, o); o = MFMA32(itc[1], p1, o);
            LAS float* OPc = (LAS float*)(lds + OP_OFF + (n & 1) * OP_BYTES);
#pragma unroll
            for (int i = 0; i < 16; ++i) OPc[i * 64 + lane] = o[i];
        } else {
            LAS float* OIc = (LAS float*)(lds + OI_OFF + (n & 1) * OI_BYTES);
            f32x16 o0, o1;
#pragma unroll
            for (int i = 0; i < 16; ++i) { o0[i] = 0.f; o1[i] = 0.f; }
#pragma unroll
            for (int ks = 0; ks < 8; ++ks) { const bf16x8 a = *(const LAS bf16x8*)(STc + l31 * RS + 32 * ks + 16 * half);
                const bf16x8 q0 = *(const LAS bf16x8*)(IM + QH_OFF + l31 * RS + 32 * ks + 16 * half), q1 = *(const LAS bf16x8*)(IM + QH_OFF + (32 + l31) * RS + 32 * ks + 16 * half);
                o0 = MFMA32(a, q0, o0); o1 = MFMA32(a, q1, o1); }
#pragma unroll
            for (int i = 0; i < 16; ++i) { OIc[i * 64 + lane] = o0[i]; OIc[1024 + i * 64 + lane] = o1[i]; }
        }
        if (n + 1 < NCH) HG_STAGE_STORE((n + 1) & 1);
        __syncthreads();
    }
    if (wave == 4 || wave == 5) HG_FINAL(NCH - 1);
    __syncthreads();
#undef HG_STAGE_LOAD
#undef HG_STAGE_STORE
#undef HG_ROLE_LOAD
#undef HG_D_LOAD
#undef HG_FINAL
}
}

#define XB_TMO      128
#define XB_XCNT(j)  (256  + 64 * (j))
#define XB_XSUB(j)  (1280 + 64 * (j))
#define XB_XGEN(j)  (2304 + 64 * (j))
#define XB_TOP      3328
#define XB_TOPGEN   3392
#define XCD_BAR_WORDS 3456
#define XB_SPIN_CAP (1u << 18)

__device__ __forceinline__ unsigned xb_ld(unsigned* p)              { return __hip_atomic_load(p, __ATOMIC_RELAXED, __HIP_MEMORY_SCOPE_AGENT); }
__device__ __forceinline__ unsigned xb_add(unsigned* p, unsigned v) { return __hip_atomic_fetch_add(p, v, __ATOMIC_RELAXED, __HIP_MEMORY_SCOPE_AGENT); }
__device__ __forceinline__ unsigned xb_xcc_id() { return (unsigned)__builtin_amdgcn_s_getreg((3 << 11) | 20) & 0xFu; }
#define XB_SPIN(cond, bar) do { unsigned _sp = 0; while (cond) { __builtin_amdgcn_s_sleep(1); \
    if ((++_sp & 255u) == 0u) { if (xb_ld(&(bar)[XB_TMO])) break; if (_sp > XB_SPIN_CAP) { atomicAdd(&(bar)[XB_TMO], 1u); break; } } } } while (0)

struct XcdBarrier {
    unsigned* bar; unsigned x;
    volatile LAS unsigned* st;
};

__device__ __forceinline__ XcdBarrier xcd_barrier_post(unsigned* bar, volatile LAS unsigned* st, int tid) {
    XcdBarrier b; b.bar = bar; b.x = xb_xcc_id(); b.st = st;
    if (tid == 0) (void)xb_add(&bar[XB_XCNT(b.x)], 1u);
    return b;
}
__device__ __forceinline__ void xcd_barrier_complete(unsigned* bar, unsigned x, unsigned& nloc, unsigned& nx) {
    const unsigned G = gridDim.x * gridDim.y * gridDim.z;
    unsigned sum, cnt, mine, sp = 0u;
    for (;;) {
        sum = 0u; cnt = 0u; mine = 0u;
#pragma unroll
        for (unsigned j = 0; j < 16; ++j) { const unsigned c = xb_ld(&bar[XB_XCNT(j)]); sum += c; cnt += (c > 0u) ? 1u : 0u; mine = (j == x) ? c : mine; }
        if (sum == G) break;
        __builtin_amdgcn_s_sleep(1);
        if ((++sp & 255u) == 0u) { if (xb_ld(&bar[XB_TMO])) break; if (sp > XB_SPIN_CAP) { atomicAdd(&bar[XB_TMO], 1u); break; } }
    }
    nloc = mine > 0u ? mine : 1u; nx = cnt > 0u ? cnt : 1u;
}

__device__ __forceinline__ void xcd_barrier(const XcdBarrier& b, int tid) {
    asm volatile("s_waitcnt vmcnt(0)" ::: "memory");
    __syncthreads();
    if (tid == 0) {
        unsigned* bar = b.bar;
        __builtin_amdgcn_s_waitcnt(0);
        unsigned nloc = b.st[0], nx = b.st[1];
        if (nloc == 0u) { xcd_barrier_complete(bar, b.x, nloc, nx); b.st[0] = nloc; b.st[1] = nx; }
        const unsigned old = xb_add(&bar[XB_XSUB(b.x)], 1u);
        const unsigned gen = old / nloc;
        if (old + 1u == (gen + 1u) * nloc) {
            __builtin_amdgcn_fence(__ATOMIC_RELEASE, "agent");
            asm volatile("s_waitcnt vmcnt(0)" ::: "memory");
            const unsigned og = xb_add(&bar[XB_TOP], 1u);
            const unsigned tg = og / nx;
            if (og + 1u == (tg + 1u) * nx) xb_add(&bar[XB_TOPGEN], 1u);
            else XB_SPIN(xb_ld(&bar[XB_TOPGEN]) == tg, bar);
            __builtin_amdgcn_fence(__ATOMIC_ACQUIRE, "agent");
            xb_add(&bar[XB_XGEN(b.x)], 1u);
            asm volatile("s_waitcnt vmcnt(0)" ::: "memory");
        } else {
            XB_SPIN(xb_ld(&bar[XB_XGEN(b.x)]) == gen, bar);
            __builtin_amdgcn_fence(__ATOMIC_ACQUIRE, "agent");
            asm volatile("s_waitcnt vmcnt(0)" ::: "memory");
        }
    }
    __syncthreads();
}


__device__ __forceinline__ void wg_arrive(unsigned* ctr, int tid) {
    asm volatile("s_waitcnt vmcnt(0)" ::: "memory"); __syncthreads();
    if (tid == 0) { __builtin_amdgcn_fence(__ATOMIC_RELEASE, "agent"); asm volatile("s_waitcnt vmcnt(0)" ::: "memory"); (void)__hip_atomic_fetch_add(ctr, 1u, __ATOMIC_RELAXED, __HIP_MEMORY_SCOPE_AGENT); }
}
__device__ __forceinline__ void wg_wait(unsigned* ctr, unsigned want, int tid) {
    if (tid == 0) { unsigned sp = 0; while (__hip_atomic_load(ctr, __ATOMIC_RELAXED, __HIP_MEMORY_SCOPE_AGENT) < want) { __builtin_amdgcn_s_sleep(4); if (++sp > (1u << 22)) break; }
        __builtin_amdgcn_fence(__ATOMIC_ACQUIRE, "agent"); asm volatile("s_waitcnt vmcnt(0)" ::: "memory"); }
    __syncthreads();
}
typedef const __attribute__((address_space(4))) Ptrs* KPtr;
#define WSP() ({ unsigned char* w_ = KP->ws; asm volatile("" : "+s"(w_)); w_; })
#define GBP() ({ unsigned char* g_ = g_buf; asm volatile("" : "+s"(g_)); g_; })
#define PH_BEGIN unsigned char* ws = WSP(); unsigned char* gb = GBP(); int wave = wave0; asm volatile("" : "+s"(wave)); const int G = gridDim.x, bx = blockIdx.x; (void)ws; (void)gb; (void)G; (void)bx;
#define IDS const int lane = fresh_lane(); const int tid = wave * 64 + lane; (void)tid; (void)lane
__global__ void __launch_bounds__(NT, 2) fwd(Ptrs P_unused) {
    KPtr KP = (KPtr)__builtin_amdgcn_kernarg_segment_ptr();
#define P (*KP)
    extern __shared__ __attribute__((aligned(16))) unsigned char lds_raw[];
    LAS unsigned char* lds = (LAS unsigned char*)lds_raw;
    const int wave0 = __builtin_amdgcn_readfirstlane((int)threadIdx.x >> 6);
    const int lo = P.ph_lo, hi = P.ph_hi;
#define IN(k) (lo <= (k) && (k) < hi)
#define SEAM(k) do { if (IN(k) && IN((k) + 1)) { if ((k) == 0) cg::this_grid().sync(); else { PH_BEGIN; IDS; XcdBarrier bar; bar.bar = (unsigned*)(ws + WS_CTL) + CW_BAR; bar.x = xb_xcc_id(); bar.st = (volatile LAS unsigned*)(lds + MISC_OFF + 32); xcd_barrier(bar, tid); } } } while (0)
    if (hi - lo > 1) { PH_BEGIN; IDS; volatile LAS unsigned* st = (volatile LAS unsigned*)(lds + MISC_OFF + 32); if (tid < 2) st[tid] = 0u; __syncthreads(); (void)xcd_barrier_post((unsigned*)(ws + WS_CTL) + CW_BAR, st, tid); }

    if (IN(0)) { p0_prologue(KP, lds, wave0); }
    SEAM(0);
    if (IN(1)) { PH_BEGIN;
        { pg8::Gemm g{(const bf16*)(ws + WS_XN), (const bf16*)(ws + WS_W1A), M, 2 * DFF, D}; pg8::StaticOrder S; S.init(M, 2 * DFF, G, bx); pg8::EpiSwiglu E{(bf16*)(ws + WS_HID), DFF};
          pg8::gemm_phase<pg8::EpiSwiglu, pg8::StaticOrder, true, true>(lds, g, S, E, wave); }
        { pg8::Gemm g{(const bf16*)(ws + WS_MEMN), (const bf16*)(ws + WS_WMKV), MROWS, 2 * D, D}; pg8::ListOrder S{MROWS / 256, G >= 144 ? 128 : 0, 16, bx}; pg8::EpiMemKV E{(bf16*)(ws + WS_KM), (bf16*)(ws + WS_VTM)};
          pg8::gemm_phase<pg8::EpiMemKV, pg8::ListOrder, false, true>(lds, g, S, E, wave); }
    }
    SEAM(1);
    if (IN(2)) { PH_BEGIN; pg8::Gemm g{(const bf16*)(ws + WS_HID), (const bf16*)(ws + WS_W1D), M, D, DFF}; pg8::StaticOrder S; S.init(M, D, G, bx); pg8::EpiBf16P E{(bf16*)(gb + GB_Z), D, 1.0f};
        pg8::gemm_phase<pg8::EpiBf16P, pg8::StaticOrder, true, true>(lds, g, S, E, wave); }
    SEAM(2);
    if (IN(3)) { PH_BEGIN; rowpass<true, true>(P.x, (const bf16*)(gb + GB_Z), P.f1pg, 0.5f, P.out, P.mixg, (bf16*)(ws + WS_XN), (const float*)(ws + WS_WF), P.fbias, (float*)(ws + WS_LC), (float*)(ws + WS_BT), lds, wave); }
    SEAM(3);
    if (IN(4)) { PH_BEGIN;
        { pg8::Gemm g{(const bf16*)(ws + WS_XN), (const bf16*)(ws + WS_WIN), M, 3072, D}; pg8::StaticOrder S; S.init(M, 3072, G, bx);
          pg8::EpiInproj E{(bf16*)(ws + WS_QA), (bf16*)(ws + WS_LF), (bf16*)(gb + GB_GA), (bf16*)(gb + GB_QB), (bf16*)(gb + GB_KB), (bf16*)(gb + GB_GT), P.lbl, P.bgate, LOG2E * 0.08838834764831845f, 0};
          pg8::gemm_phase<pg8::EpiInproj, pg8::StaticOrder, true, true>(lds, g, S, E, wave); }
        { pg8::Gemm g{(const bf16*)(ws + WS_WIN) + (size_t)7168 * D, (const bf16*)(ws + WS_XN), 1024, M, D}; pg8::StaticOrder S; S.init(1024, M, G, bx); pg8::EpiBf16P E{(bf16*)(ws + WS_IT), M, 1.0f};
          pg8::gemm_phase<pg8::EpiBf16P, pg8::StaticOrder, true, true>(lds, g, S, E, wave); }
    }
    SEAM(4);
    if (IN(5)) { PH_BEGIN;
        for (int it = bx; it < 2048; it += G) hg::prepass_item(lds, it, (bf16*)(ws + WS_QA), (bf16*)(ws + WS_LF), (bf16*)(gb + GB_KHT), (float*)(ws + WS_D1), (float*)(ws + WS_D2), wave);
    }
    SEAM(5);
    if (IN(6)) { PH_BEGIN;
        unsigned* ctl = (unsigned*)(ws + WS_CTL);
        constexpr int NH_ = 64;
        const int GW = G - NH_;
        if (bx < NH_) { hg::unit(lds, bx, (const bf16*)(ws + WS_QA), (const bf16*)(ws + WS_LF), (const bf16*)(gb + GB_KHT), (const float*)(ws + WS_D1), (const float*)(ws + WS_D2), (const bf16*)(ws + WS_IT), (bf16*)(gb + GB_GA), P.hgg, (float*)(ws + WS_SSQ), wave); }
        if (bx >= NH_) { const int c = bx - NH_;
            { pg8::Gemm g{(const bf16*)(ws + WS_XN), (const bf16*)(ws + WS_WIN) + (size_t)3072 * D, M, 4096, D}; pg8::StaticOrder S; S.init(M, 4096, GW, c);
              pg8::EpiInproj E{(bf16*)(ws + WS_QA), (bf16*)(ws + WS_LF), (bf16*)(gb + GB_GA), (bf16*)(gb + GB_QB), (bf16*)(gb + GB_KB), (bf16*)(gb + GB_GT), P.lbl, P.bgate, LOG2E * 0.08838834764831845f, 12};
              pg8::gemm_phase<pg8::EpiInproj, pg8::StaticOrder, true, true>(lds, g, S, E, wave); }
            { pg8::Gemm g{(const bf16*)(ws + WS_WIN) + (size_t)8192 * D, (const bf16*)(ws + WS_XN), 1024, M, D}; pg8::StaticOrder S; S.init(1024, M, GW, c); pg8::EpiBf16P E{(bf16*)(ws + WS_VT), M, 1.0f};
              pg8::gemm_phase<pg8::EpiBf16P, pg8::StaticOrder, true, true>(lds, g, S, E, wave); }
            { IDS; wg_arrive(ctl + 64, tid); wg_wait(ctl + 64, (unsigned)GW, tid); }
            for (int w = c; w < M / 64; w += GW) fox::kmax_block(lds, w, (const bf16*)(gb + GB_KB), (float*)(ws + WS_KMAXP), wave);
            { IDS; wg_arrive(ctl + 128, tid); }
        }
        LAS int* sh = (LAS int*)(lds + MISC_OFF); IDS;
        wg_wait(ctl + 128, (unsigned)GW, tid);
        for (;;) {
            __syncthreads();
            if (tid == 0) sh[0] = (int)atomicAdd(ctl, 1u);
            __syncthreads();
            const int u = sh[0];
            if (u >= 512) break;
            fox::unit(lds, u, (bf16*)(gb + GB_QB), (const bf16*)(gb + GB_KB), (const bf16*)(ws + WS_VT), (const float*)(ws + WS_LC), (const float*)(ws + WS_BT), (const float*)(ws + WS_KMAXP), wave);
        }
    }
    SEAM(6);
    if (IN(7)) { PH_BEGIN;
        pg8::StaticOrder S; S.init(M, D, G, bx); float* RSTD = (float*)(ws + WS_RSTD);
        { IDS; const float* SSQ = (const float*)(ws + WS_SSQ); pg8::Unit u; for (int i = 0; S.next(i, u); ++i) { const int r = tid >> 1, sub = tid & 1; const float* sp = SSQ + (size_t)(u.pm * 256 + r) * 32 + 16 * sub; float s = 0.f;
#pragma unroll
                for (int j = 0; j < 16; ++j) s += sp[j];
                s += __shfl_xor(s, 1);
                if (sub == 0) RSTD[(size_t)u.pn * M + u.pm * 256 + r] = 1.0f / sqrtf(s * (1.0f / D) + EPS); } }
        __threadfence(); __syncthreads();
        { pg8::Gemm g{(const bf16*)(gb + GB_GA), (const bf16*)(ws + WS_WBA), M, D, D}; pg8::EpiBranchA E{(bf16*)(gb + GB_GT), RSTD}; pg8::gemm_phase<pg8::EpiBranchA, pg8::StaticOrder, true, true>(lds, g, S, E, wave); }
        { pg8::Gemm g{(const bf16*)(gb + GB_QB), (const bf16*)(ws + WS_WBB), M, D, D}; pg8::EpiBranchB E{(const bf16*)(gb + GB_GT), (bf16*)(ws + WS_Y)}; pg8::gemm_phase<pg8::EpiBranchB, pg8::StaticOrder, true, true>(lds, g, S, E, wave); }
    }
    SEAM(7);
    if (IN(8)) { PH_BEGIN; pg8::Gemm g{(const bf16*)(ws + WS_Y), (const bf16*)(ws + WS_WOUT), M, D, D}; pg8::StaticOrder S; S.init(M, D, G, bx); pg8::EpiBf16P E{(bf16*)(gb + GB_Z), D, 1.0f}; pg8::gemm_phase<pg8::EpiBf16P, pg8::StaticOrder, true, true>(lds, g, S, E, wave); }
    SEAM(8);
    if (IN(9)) { PH_BEGIN; rowpass<true, false>(P.out, (const bf16*)(gb + GB_Z), P.mixpg, 1.0f, P.out, P.mempg, (bf16*)(ws + WS_XN), nullptr, nullptr, nullptr, nullptr, lds, wave); }
    SEAM(9);
    if (IN(10)) { PH_BEGIN; pg8::Gemm g{(const bf16*)(ws + WS_XN), (const bf16*)(ws + WS_WMQ), M, D, D}; pg8::StaticOrder S; S.init(M, D, G, bx); pg8::EpiHeadSplit E{(bf16*)(ws + WS_QMH), M, LOG2E * 0.0625f};
        pg8::gemm_phase<pg8::EpiHeadSplit, pg8::StaticOrder, true, true>(lds, g, S, E, wave); }
    SEAM(10);
    if (IN(11)) { PH_BEGIN;
        pg8::CrossOrder S; S.so.init(M, D, G, bx); S.Mrows = M; S.pm_per_batch = SEQ / 256;
        { pg8::Gemm g{(const bf16*)(ws + WS_QMH), (const bf16*)(ws + WS_KM), M, D, 256}; pg8::EpiSoftmax E{(bf16*)(ws + WS_P), M}; pg8::gemm_phase<pg8::EpiSoftmax, pg8::CrossOrder, false, true>(lds, g, S, E, wave); }
        __threadfence(); __syncthreads();
        { pg8::Gemm g{(const bf16*)(ws + WS_P), (const bf16*)(ws + WS_VTM), M, D, 256}; pg8::EpiBf16P E{(bf16*)(ws + WS_OM), D, 1.0f}; pg8::gemm_phase<pg8::EpiBf16P, pg8::CrossOrder, true, true>(lds, g, S, E, wave); }
    }
    SEAM(11);
    if (IN(12)) { PH_BEGIN; pg8::Gemm g{(const bf16*)(ws + WS_OM), (const bf16*)(ws + WS_WMO), M, D, D}; pg8::StaticOrder S; S.init(M, D, G, bx); pg8::EpiBf16P E{(bf16*)(gb + GB_Z), D, 1.0f}; pg8::gemm_phase<pg8::EpiBf16P, pg8::StaticOrder, true, true>(lds, g, S, E, wave); }
    SEAM(12);
    if (IN(13)) { PH_BEGIN; rowpass<true, false>(P.out, (const bf16*)(gb + GB_Z), P.mempostg, 1.0f, P.out, P.f2g, (bf16*)(ws + WS_XN), nullptr, nullptr, nullptr, nullptr, lds, wave); }
    SEAM(13);
    if (IN(14)) { PH_BEGIN; pg8::Gemm g{(const bf16*)(ws + WS_XN), (const bf16*)(ws + WS_W2A), M, 2 * DFF, D}; pg8::StaticOrder S; S.init(M, 2 * DFF, G, bx); pg8::EpiSwiglu E{(bf16*)(ws + WS_HID), DFF};
        pg8::gemm_phase<pg8::EpiSwiglu, pg8::StaticOrder, true, true>(lds, g, S, E, wave); }
    SEAM(14);
    if (IN(15)) { PH_BEGIN; pg8::Gemm g{(const bf16*)(ws + WS_HID), (const bf16*)(ws + WS_W2D), M, D, DFF}; pg8::StaticOrder S; S.init(M, D, G, bx); pg8::EpiBf16P E{(bf16*)(gb + GB_Z), D, 1.0f}; pg8::gemm_phase<pg8::EpiBf16P, pg8::StaticOrder, true, true>(lds, g, S, E, wave); }
    SEAM(15);
    if (IN(16)) { PH_BEGIN; rowpass<false, false>(P.out, (const bf16*)(gb + GB_Z), P.f2pg, 0.5f, P.out, nullptr, nullptr, nullptr, nullptr, nullptr, nullptr, lds, wave); }
#undef IN
#undef SEAM
#undef P
}

extern "C" void kernel_launch(void* const* d_in, const int* in_sizes, int n_in, void* d_out, int out_size, void* d_ws, size_t ws_size, hipStream_t stream) {
    static int grid = 0;
    if (grid == 0) {
        if (n_in != 26 || in_sizes[0] != M * D || out_size != M * D || ws_size < WS_END) { fprintf(stderr, "kernel_launch: unexpected problem (n_in %d, ws %zu)\n", n_in, ws_size); grid = -1; return; }
        int dev = 0, cus = 0, per_cu = 0;
        if (hipGetDevice(&dev) != hipSuccess || hipDeviceGetAttribute(&cus, hipDeviceAttributeMultiprocessorCount, dev) != hipSuccess) { grid = -1; return; }
        if (hipFuncSetAttribute((const void*)fwd, hipFuncAttributeMaxDynamicSharedMemorySize, LDS_BYTES) != hipSuccess) { fprintf(stderr, "kernel_launch: hipFuncSetAttribute failed\n"); grid = -1; return; }
        if (hipOccupancyMaxActiveBlocksPerMultiprocessor(&per_cu, (const void*)fwd, NT, LDS_BYTES) != hipSuccess || per_cu < 1) { fprintf(stderr, "kernel_launch: occupancy query gave %d\n", per_cu); (void)hipGetLastError(); grid = -1; return; }
        grid = cus * 1;
    }
    if (grid < 0) return;
    (void)hipMemsetAsync((char*)d_ws + WS_CTL, 0, CTL_ZERO_BYTES, stream);
    Ptrs p{};
    const float** pf = (const float**)&p;
    for (int i = 0; i < 26; ++i) pf[i] = (const float*)d_in[i];
    p.out = (float*)d_out; p.ws = (unsigned char*)d_ws;
#if ONE_LAUNCH
    p.ph_lo = 0; p.ph_hi = NPHASE;
    void* args[] = {&p};
    hipError_t e = hipLaunchCooperativeKernel((const void*)fwd, dim3(grid), dim3(NT), args, LDS_BYTES, stream);
    if (e != hipSuccess) fprintf(stderr, "cooperative launch failed: %s (grid %d)\n", hipGetErrorString(e), grid);
#else
    for (int k = 0; k < NPHASE; ++k) { p.ph_lo = k; p.ph_hi = k + 1; hipLaunchKernelGGL(fwd, dim3(grid), dim3(NT), LDS_BYTES, stream, p); }
#endif
}
```
